# Optimizing an MI355X kernel written in HIP

```python
import math
import jax
import jax.numpy as jnp
from jax import lax
import numpy as np

D_MODEL = 2048
BATCH = 4
SEQ = 2048
DEPTH = 2
DEC_BATCH = 8
DEC_SEQ = 4096
PAST_LEN = 128

HEAD_DIM = 64
N_HEADS_TOTAL = D_MODEL // HEAD_DIM
H_C = N_HEADS_TOTAL // 4
H_A = (N_HEADS_TOTAL - H_C) // 2
H_B = N_HEADS_TOTAL - H_C - H_A
KV_A = H_A // 4
KV_B = H_B // 4
KV_C = H_C // 4
C_PATTERNS = ((128, 1), (512, 4), (2048, 16))
N_C_GROUPS = len(C_PATTERNS)
D_MIX = (H_A + H_B + H_C) * HEAD_DIM
BLOCK = 128
WIN_A = 128
GRID_W = 64
ROPE_THETA = 10000.0
T5_BUCKETS = 32
T5_MAX_DISTANCE = 1024
N_BIAS_HEADS = H_A + N_C_GROUPS * H_C
RMS_EPS = 1e-6
NEG_INF = -1e30
SPLIT_SIZES = (
    H_A * HEAD_DIM, KV_A * HEAD_DIM, KV_A * HEAD_DIM, H_A * HEAD_DIM,
    H_B * HEAD_DIM, KV_B * HEAD_DIM, KV_B * HEAD_DIM, H_B * HEAD_DIM,
    N_C_GROUPS * H_C * HEAD_DIM, N_C_GROUPS * KV_C * HEAD_DIM, N_C_GROUPS * KV_C * HEAD_DIM, H_C * HEAD_DIM,
)
D_IN_PROJ = sum(SPLIT_SIZES)

kernel_name = "hybrid_parallel_group_encoder"


def rms_norm(x, g):
    xf = x.astype(jnp.float32)
    xf = xf * lax.rsqrt(jnp.mean(xf * xf, axis=-1, keepdims=True) + RMS_EPS)
    return xf * g.astype(jnp.float32)


def t5_bucket(rel):
    half = T5_BUCKETS // 2
    max_exact = half // 2
    n = jnp.abs(rel)
    log_ratio = jnp.log(jnp.maximum(n, 1).astype(jnp.float32) / max_exact) / math.log(T5_MAX_DISTANCE / max_exact)
    large = jnp.minimum(max_exact + (log_ratio * (half - max_exact)).astype(jnp.int32), half - 1)
    return jnp.where(rel > 0, half, 0) + jnp.where(n < max_exact, n, large)


def rotate_axis(x, ang):
    n2 = x.shape[-1] // 2
    x1, x2 = x[..., :n2], x[..., n2:]
    c = jnp.cos(ang)[None, :, None, :]
    s = jnp.sin(ang)[None, :, None, :]
    return jnp.concatenate([x1 * c - x2 * s, x1 * s + x2 * c], axis=-1)


def axial_rope(x, ang_row, ang_col):
    half = HEAD_DIM // 2
    return jnp.concatenate([rotate_axis(x[..., :half], ang_row), rotate_axis(x[..., half:], ang_col)], axis=-1)


def window_sink_attention(q, k, v, sink, rel_bias):
    B, S = q.shape[0], q.shape[1]
    nb = S // BLOCK
    R = H_A // KV_A
    span = BLOCK + 2 * WIN_A
    qb = (q * HEAD_DIM ** -0.5).reshape(B, nb, BLOCK, KV_A, R, HEAD_DIM).transpose(1, 0, 2, 3, 4, 5)
    pad = ((0, 0), (WIN_A, WIN_A), (0, 0), (0, 0))
    kp = jnp.pad(k.astype(jnp.float32), pad)
    vp = jnp.pad(v.astype(jnp.float32), pad)
    rel = jnp.arange(span, dtype=jnp.int32)[None, :] - WIN_A - jnp.arange(BLOCK, dtype=jnp.int32)[:, None]
    band = jnp.abs(rel) <= WIN_A
    bias = rel_bias[t5_bucket(rel)][:, :, :H_A]
    bias = bias.transpose(2, 0, 1).reshape(KV_A, R, BLOCK, span).astype(jnp.float32)
    sink_l = sink.astype(jnp.float32).reshape(KV_A, R, 1)

    def one_block(args):
        qblk, start = args
        kb = lax.dynamic_slice_in_dim(kp, start, span, axis=1)
        vb = lax.dynamic_slice_in_dim(vp, start, span, axis=1)
        kpos = start - WIN_A + jnp.arange(span, dtype=jnp.int32)
        mask = band & ((kpos >= 0) & (kpos < S))[None, :]
        s = jnp.einsum('bqhrd,bkhd->bhrqk', qblk, kb) + bias
        s = jnp.where(mask, s, NEG_INF)
        m = jnp.maximum(jnp.max(s, axis=-1), sink_l)
        e = jnp.exp(s - m[..., None])
        denom = jnp.sum(e, axis=-1) + jnp.exp(sink_l - m)
        return jnp.einsum('bhrqk,bkhd->bqhrd', e / denom[..., None], vb)

    starts = jnp.arange(nb, dtype=jnp.int32) * BLOCK
    o = lax.map(one_block, (qb, starts))
    return o.transpose(1, 0, 2, 3, 4, 5).reshape(B, S, H_A * HEAD_DIM)


def global_axial_attention(q, k, v):
    B, S = q.shape[0], q.shape[1]
    nb = S // BLOCK
    R = H_B // KV_B
    qb = (q * HEAD_DIM ** -0.5).reshape(B, nb, BLOCK, KV_B, R, HEAD_DIM).transpose(1, 0, 2, 3, 4, 5)
    kf = k.astype(jnp.float32)
    vf = v.astype(jnp.float32)

    def one_block(qblk):
        s = jnp.einsum('bqhrd,bkhd->bhrqk', qblk, kf)
        p = jax.nn.softmax(s, axis=-1)
        return jnp.einsum('bhrqk,bkhd->bqhrd', p, vf)

    o = lax.map(one_block, qb)
    return o.transpose(1, 0, 2, 3, 4, 5).reshape(B, S, H_B * HEAD_DIM)


def dilated_mixture_attention(q, k, v, rel_bias):
    B, S = q.shape[0], q.shape[1]
    nb = S // BLOCK
    R = H_C // KV_C
    qb = (q * HEAD_DIM ** -0.5).reshape(B, nb, BLOCK, N_C_GROUPS, KV_C, R, HEAD_DIM).transpose(1, 0, 2, 3, 4, 5, 6)
    kf = k.astype(jnp.float32).reshape(B, S, N_C_GROUPS, KV_C, HEAD_DIM)
    vf = v.astype(jnp.float32).reshape(B, S, N_C_GROUPS, KV_C, HEAD_DIM)
    k_groups = [kf[:, :, g] for g in range(N_C_GROUPS)]
    v_groups = [vf[:, :, g] for g in range(N_C_GROUPS)]
    offsets, biases = [], []
    for g, (w, d) in enumerate(C_PATTERNS):
        radius = w // (2 * d)
        off = jnp.arange(-radius, radius + 1, dtype=jnp.int32) * d
        b = rel_bias[t5_bucket(off)][:, H_A + g * H_C: H_A + (g + 1) * H_C]
        biases.append(b.T.reshape(KV_C, R, 1, off.shape[0]).astype(jnp.float32))
        offsets.append(off)

    def one_block(args):
        qblk, start = args
        qpos = start + jnp.arange(BLOCK, dtype=jnp.int32)
        outs, lses = [], []
        for g in range(N_C_GROUPS):
            idx = qpos[:, None] + offsets[g][None, :]
            valid = (idx >= 0) & (idx < S)
            idxc = jnp.clip(idx, 0, S - 1)
            kg = k_groups[g][:, idxc]
            vg = v_groups[g][:, idxc]
            s = jnp.einsum('bqhrd,bqkhd->bhrqk', qblk[:, :, g], kg) + biases[g]
            s = jnp.where(valid[None, None, None], s, NEG_INF)
            lse = jax.nn.logsumexp(s, axis=-1)
            p = jnp.exp(s - lse[..., None])
            outs.append(jnp.einsum('bhrqk,bqkhd->bqhrd', p, vg))
            lses.append(lse)
        alpha = jax.nn.softmax(jnp.stack(lses, axis=0), axis=0).transpose(0, 1, 4, 2, 3)
        return jnp.sum(jnp.stack(outs, axis=0) * alpha[..., None], axis=0)

    starts = jnp.arange(nb, dtype=jnp.int32) * BLOCK
    o = lax.map(one_block, (qb, starts))
    return o.transpose(1, 0, 2, 3, 4, 5).reshape(B, S, H_C * HEAD_DIM)


def trunk(x, ln_g, w_in, q_norm_a, k_norm_a, sink_a, q_norm_b, k_norm_b, q_norm_c, k_norm_c, rel_bias, w_out):
    B, S = x.shape[0], x.shape[1]
    rows = S // GRID_W
    row = jnp.repeat(jnp.arange(rows, dtype=jnp.int32), GRID_W)
    col = jnp.arange(S, dtype=jnp.int32) % GRID_W
    n_freq = HEAD_DIM // 4
    inv_freq = ROPE_THETA ** (-jnp.arange(n_freq, dtype=jnp.float32) / n_freq)
    ang_row = row.astype(jnp.float32)[:, None] * inv_freq[None, :]
    ang_col = col.astype(jnp.float32)[:, None] * inv_freq[None, :]
    points = np.cumsum(SPLIT_SIZES)[:-1].tolist()

    def heads(t):
        return t.reshape(B, S, -1, HEAD_DIM)

    for l in range(DEPTH):
        h = rms_norm(x, ln_g[l]).astype(x.dtype)
        proj = jnp.einsum('bsd,de->bse', h, w_in[l])
        qa, ka, va, ga, qb, kb, vb, gb, qc, kc, vc, gc = jnp.split(proj, points, axis=-1)
        ya = window_sink_attention(rms_norm(heads(qa), q_norm_a[l]), rms_norm(heads(ka), k_norm_a[l]),
                                   heads(va), sink_a[l], rel_bias)
        yb = global_axial_attention(axial_rope(rms_norm(heads(qb), q_norm_b[l]), ang_row, ang_col),
                                    axial_rope(rms_norm(heads(kb), k_norm_b[l]), ang_row, ang_col),
                                    heads(vb))
        yc = dilated_mixture_attention(rms_norm(heads(qc), q_norm_c[l]), rms_norm(heads(kc), k_norm_c[l]),
                                       heads(vc), rel_bias)
        mix = jnp.concatenate([ya * jax.nn.silu(ga.astype(jnp.float32)),
                               yb * jax.nn.silu(gb.astype(jnp.float32)),
                               yc * jax.nn.silu(gc.astype(jnp.float32))], axis=-1).astype(x.dtype)
        x = x + jnp.einsum('bse,ed->bsd', mix, w_out[l]).astype(x.dtype)
    return x


def setup_inputs(seed: int = 0) -> dict:
    key = jax.random.key(seed)
    ks = jax.random.split(key, 13)
    f32 = jnp.float32
    return {
        "x_prompt": jax.random.normal(ks[0], (BATCH, SEQ, D_MODEL), f32),
        "x_sample": jax.random.normal(ks[1], (DEC_BATCH, DEC_SEQ, D_MODEL), f32),
        "ln_g": 1.0 + 0.05 * jax.random.normal(ks[2], (DEPTH, D_MODEL), f32),
        "w_in": jax.random.normal(ks[3], (DEPTH, D_MODEL, D_IN_PROJ), f32) * D_MODEL ** -0.5,
        "q_norm_a": 1.0 + 0.05 * jax.random.normal(ks[4], (DEPTH, HEAD_DIM), f32),
        "k_norm_a": 1.0 + 0.05 * jax.random.normal(ks[5], (DEPTH, HEAD_DIM), f32),
        "sink_a": 0.5 * jax.random.normal(ks[6], (DEPTH, H_A), f32),
        "q_norm_b": 1.0 + 0.05 * jax.random.normal(ks[7], (DEPTH, HEAD_DIM), f32),
        "k_norm_b": 1.0 + 0.05 * jax.random.normal(ks[8], (DEPTH, HEAD_DIM), f32),
        "q_norm_c": 1.0 + 0.05 * jax.random.normal(ks[9], (DEPTH, HEAD_DIM), f32),
        "k_norm_c": 1.0 + 0.05 * jax.random.normal(ks[10], (DEPTH, HEAD_DIM), f32),
        "rel_bias": 0.1 * jax.random.normal(ks[11], (T5_BUCKETS, N_BIAS_HEADS), f32),
        "w_out": jax.random.normal(ks[12], (DEPTH, D_MIX, D_MODEL), f32) * D_MIX ** -0.5,
    }


def reference(x_prompt, x_sample, ln_g, w_in, q_norm_a, k_norm_a, sink_a, q_norm_b, k_norm_b,
              q_norm_c, k_norm_c, rel_bias, w_out):
    y_prompt = trunk(x_prompt, ln_g, w_in, q_norm_a, k_norm_a, sink_a, q_norm_b, k_norm_b,
                     q_norm_c, k_norm_c, rel_bias, w_out)
    y_sample = trunk(x_sample, ln_g, w_in, q_norm_a, k_norm_a, sink_a, q_norm_b, k_norm_b,
                     q_norm_c, k_norm_c, rel_bias, w_out)
    return (y_prompt, y_sample)
```

```cpp
#include <hip/hip_runtime.h>
#include <hip/hip_cooperative_groups.h>
#include <cstdio>
#include <cstdint>
namespace cg = cooperative_groups;

constexpr int DM = 2048, NP = 6656, MP = 8192, MS = 32768, MT = MP + MS;
constexpr int C_QA = 0, C_KA = 768, C_VA = 960, C_GA = 1152, C_QB = 1920, C_KB = 2688, C_VB = 2880, C_GB = 3072, C_QC = 3840, C_KC = 5376, C_VC = 5760, C_GC = 6144;
constexpr float QSCALE = 0.125f * 1.4426950408889634f;
constexpr float LOG2E = 1.4426950408889634f;
constexpr float RMS_EPS = 1e-6f;

namespace pg8 {
#define PG8_LAS __attribute__((address_space(3)))
typedef unsigned short bf16_t;
typedef short bf16x8 __attribute__((ext_vector_type(8)));
typedef float f32x4 __attribute__((ext_vector_type(4)));
typedef unsigned u32x4 __attribute__((ext_vector_type(4)));
constexpr int BM = 256, BK = 64, HALF = 128, HTB = HALF * BK * 2  , STAGE_BYTES = 8 * HTB, NXCD = 8, WGM = 8;

__host__ __device__ __forceinline__ int lds_byte(int r, int c) { const int st = (r >> 4) * 2 + (c >> 5), rr = r & 15, cc = c & 31, ob = rr * 64 + cc * 2; return st * 1024 + (ob ^ (((ob >> 9) & 1) << 5)); }
__host__ __device__ __forceinline__ void stage_rc(int b, int& R, int& C) { const int st = b / 1024, sb = b % 1024, swz = sb ^ (((sb >> 9) & 1) << 5); R = (st >> 1) * 16 + swz / 64; C = (st & 1) * 32 + (swz % 64) / 2; }
__host__ __device__ __forceinline__ int perm32(int rho) { const int n = rho >> 4, i = rho & 15; return 8 * (i >> 2) + 4 * n + (i & 3); }

struct Unit { int pm, pn; };
struct Gemm { const bf16_t* A; const bf16_t* Bt; int M, N, K; };

struct StaticOrder {
    int nM, nN, nwg, G, c;
    __host__ __device__ void init(int M, int N, int G_, int c_) { nM = M / BM; nN = N / BM; nwg = nM * nN; G = G_; c = c_; }
    __host__ __device__ bool next(int i, Unit& u) const {
        const long L = (long)i * G + c; if (L >= nwg) return false;
        int wgid = (int)L; { const int q = nwg / NXCD, r = nwg % NXCD, xcd = wgid % NXCD, off = wgid / NXCD; wgid = (xcd < r ? xcd * (q + 1) : r * (q + 1) + (xcd - r) * q) + off; }
        const int nig = WGM * nN, gid = wgid / nig, fm = gid * WGM, gsz = (nM - fm) < WGM ? (nM - fm) : WGM;
        u.pm = fm + ((wgid % nig) % gsz); u.pn = (wgid % nig) / gsz; return true;
    }
    __device__ __forceinline__ void a_ready(const Unit&) const {}
    __device__ __forceinline__ void done(const Unit&) const {}
};

__device__ __forceinline__ unsigned cvt_pk_bf16(float lo, float hi) { unsigned r; asm volatile("v_cvt_pk_bf16_f32 %0, %1, %2" : "=v"(r) : "v"(lo), "v"(hi)); return r; }
typedef float f32x2e __attribute__((ext_vector_type(2)));
struct EpiProj {
    static constexpr bool PERM = true, AFTER_DRAIN = false;
    bf16_t* P; const float *qna, *kna, *qnb, *knb, *qnc, *knc; const float* rope;
    __device__ __forceinline__ void operator()(const f32x4 (&acc)[2][2][4][2], const Unit& u, int wr, int wc, int fr, int fq) const {
        const int hd = u.pn * 4 + wc;
        int type; const float* w = qna; float qs = 1.f;
        if (hd < 12) { type = 2; w = qna; qs = QSCALE; } else if (hd < 15) { type = 2; w = kna; } else if (hd < 18) { type = 0; } else if (hd < 30) { type = 1; }
        else if (hd < 42) { type = 3; w = qnb; qs = QSCALE; } else if (hd < 45) { type = 3; w = knb; } else if (hd < 48) { type = 0; } else if (hd < 60) { type = 1; }
        else if (hd < 84) { type = 2; w = qnc; qs = QSCALE; } else if (hd < 90) { type = 2; w = knc; } else if (hd < 96) { type = 0; } else { type = 1; }
        const int row0 = u.pm * BM + wr * 64 + fr;
        bf16_t* base = P + (size_t)row0 * NP + hd * 64 + 8 * fq;
        if (type == 0) {
#pragma unroll
            for (int ai = 0; ai < 2; ++ai)
#pragma unroll
                for (int m = 0; m < 4; ++m) { bf16_t* rowp = base + (size_t)(ai * HALF + m * 16) * NP;
#pragma unroll
                    for (int bj = 0; bj < 2; ++bj) { const f32x4 v0 = acc[ai][bj][m][0], v1 = acc[ai][bj][m][1]; u32x4 o;
                        o.x = cvt_pk_bf16(v0[0], v0[1]); o.y = cvt_pk_bf16(v0[2], v0[3]); o.z = cvt_pk_bf16(v1[0], v1[1]); o.w = cvt_pk_bf16(v1[2], v1[3]);
                        *(u32x4*)(rowp + bj * 32) = o; } }
        } else if (type == 1) {
#pragma unroll
            for (int ai = 0; ai < 2; ++ai)
#pragma unroll
                for (int m = 0; m < 4; ++m) { bf16_t* rowp = base + (size_t)(ai * HALF + m * 16) * NP;
#pragma unroll
                    for (int bj = 0; bj < 2; ++bj) { f32x4 v[2] = {acc[ai][bj][m][0], acc[ai][bj][m][1]};
#pragma unroll
                        for (int n = 0; n < 2; ++n)
#pragma unroll
                            for (int e = 0; e < 4; ++e) { const float g = v[n][e]; v[n][e] = g * __builtin_amdgcn_rcpf(1.f + __builtin_amdgcn_exp2f(-g * LOG2E)); }
                        u32x4 o; o.x = cvt_pk_bf16(v[0][0], v[0][1]); o.y = cvt_pk_bf16(v[0][2], v[0][3]); o.z = cvt_pk_bf16(v[1][0], v[1][1]); o.w = cvt_pk_bf16(v[1][2], v[1][3]);
                        *(u32x4*)(rowp + bj * 32) = o; } }
        } else {
            f32x4 wv[2][2];
#pragma unroll
            for (int bj = 0; bj < 2; ++bj)
#pragma unroll
                for (int n = 0; n < 2; ++n) wv[bj][n] = *(const f32x4*)(w + 32 * bj + 8 * fq + 4 * n);
            const float sgn = (fq < 2) ? -1.f : 1.f;
#pragma unroll
            for (int ai = 0; ai < 2; ++ai)
#pragma unroll
                for (int m = 0; m < 4; ++m) { bf16_t* rowp = base + (size_t)(ai * HALF + m * 16) * NP;
                    f32x4 v[2][2]; float ss = 0.f;
#pragma unroll
                    for (int bj = 0; bj < 2; ++bj)
#pragma unroll
                        for (int n = 0; n < 2; ++n) { v[bj][n] = acc[ai][bj][m][n]; const f32x4 x = v[bj][n]; ss += (x[0] * x[0] + x[1] * x[1]) + (x[2] * x[2] + x[3] * x[3]); }
                    ss += __shfl_xor(ss, 16); ss += __shfl_xor(ss, 32);
                    const float rs = __builtin_amdgcn_rsqf(ss * (1.0f / 64.0f) + RMS_EPS);
#pragma unroll
                    for (int bj = 0; bj < 2; ++bj)
#pragma unroll
                        for (int n = 0; n < 2; ++n) v[bj][n] = v[bj][n] * rs * wv[bj][n];
                    if (type == 3) {
                        const int r = row0 + ai * HALF + m * 16, t = r & ((r < MP) ? 2047 : 4095);
#pragma unroll
                        for (int bj = 0; bj < 2; ++bj) { const int pos = bj ? (t & 63) : (t >> 6);
#pragma unroll
                            for (int n = 0; n < 2; ++n) { const float* tp = rope + (size_t)(pos * 16 + 8 * (fq & 1) + 4 * n) * 2;
                                const f32x4 cs0 = *(const f32x4*)tp, cs1 = *(const f32x4*)(tp + 4); const f32x4 x = v[bj][n]; f32x4 pr;
                                pr[0] = __shfl_xor(x[0], 32); pr[1] = __shfl_xor(x[1], 32); pr[2] = __shfl_xor(x[2], 32); pr[3] = __shfl_xor(x[3], 32);
                                f32x4 y; y[0] = x[0] * cs0[0] + sgn * pr[0] * cs0[1]; y[1] = x[1] * cs0[2] + sgn * pr[1] * cs0[3];
                                y[2] = x[2] * cs1[0] + sgn * pr[2] * cs1[1]; y[3] = x[3] * cs1[2] + sgn * pr[3] * cs1[3]; v[bj][n] = y; } }
                    }
#pragma unroll
                    for (int bj = 0; bj < 2; ++bj) { const f32x4 v0 = v[bj][0] * qs, v1 = v[bj][1] * qs; u32x4 o;
                        o.x = cvt_pk_bf16(v0[0], v0[1]); o.y = cvt_pk_bf16(v0[2], v0[3]); o.z = cvt_pk_bf16(v1[0], v1[1]); o.w = cvt_pk_bf16(v1[2], v1[3]);
                        *(u32x4*)(rowp + bj * 32) = o; } }
        }
    }
};
struct EpiRes {
    static constexpr bool PERM = true, AFTER_DRAIN = false;
    const float* x0; const float* x1; float* out;
    __device__ __forceinline__ void operator()(const f32x4 (&acc)[2][2][4][2], const Unit& u, int wr, int wc, int fr, int fq) const {
        const int row0 = u.pm * BM + wr * 64 + fr, col0 = u.pn * BM + wc * 32 + 8 * fq;
        const float* xb = (row0 < MP) ? x0 + (size_t)row0 * DM : x1 + (size_t)(row0 - MP) * DM;
        float* ob = out + (size_t)row0 * DM;
#pragma unroll
        for (int ai = 0; ai < 2; ++ai)
#pragma unroll
            for (int m = 0; m < 4; ++m) { const size_t off = (size_t)(ai * HALF + m * 16) * DM + col0;
#pragma unroll
                for (int bj = 0; bj < 2; ++bj) { const f32x4 a0 = *(const f32x4*)(xb + off + bj * HALF), a1 = *(const f32x4*)(xb + off + bj * HALF + 4);
                    *(f32x4*)(ob + off + bj * HALF) = a0 + acc[ai][bj][m][0]; *(f32x4*)(ob + off + bj * HALF + 4) = a1 + acc[ai][bj][m][1]; } }
    }
};

template <class Epi, class Sched, bool ALIGN_EPI = false, bool SP2 = false>
__device__ __forceinline__ void gemm_phase(PG8_LAS unsigned char* lds, const Gemm g, const Sched& S, const Epi& E) {
    int tid_l = threadIdx.x; asm volatile("" : "+v"(tid_l));
    const int tid = tid_l, wid = __builtin_amdgcn_readfirstlane(tid >> 6), lane = tid & 63, wr = wid >> 2, wc = wid & 3, fr = lane & 15, fq = lane >> 4;
    const int K = g.K, nt = K / BK;
    unsigned voffA[2], voffB[2];
#pragma unroll
    for (int i = 0; i < 2; ++i) { int R, C; stage_rc(tid * 16 + i * 8192, R, C); const int Rb = Epi::PERM ? ((R & ~31) + perm32(R & 31)) : R;
        voffA[i] = (unsigned)(R * K + C) * 2u; voffB[i] = (unsigned)(Rb * K + C) * 2u; }
    const size_t kstep = (size_t)(BK * 2);
    const size_t hstep = (size_t)HALF * K * 2;
    const size_t tstep = 2 * hstep;
    const unsigned ldsw = (unsigned)wid * 1024u;
    const int aoff = lds_byte(wr * 64 + fr, fq * 8), boff = lds_byte(wc * 32 + fr, fq * 8);
#define PG8_SA(b, h) (((b) * 2 + (h)) * HTB)
#define PG8_SB(b, h) ((4 + (b) * 2 + (h)) * HTB)
#define PG8_STAGE(bufoff, gbase, voff) do { _Pragma("unroll") for (int _i = 0; _i < 2; ++_i) \
        __builtin_amdgcn_global_load_lds((const unsigned*)((const char*)(gbase) + (voff)[_i]), (PG8_LAS unsigned*)(lds + (bufoff) + ldsw + _i * 8192), 16, 0, 0); } while (0)
#define PG8_LDA(dst, b, h) do { _Pragma("unroll") for (int m = 0; m < 4; ++m) _Pragma("unroll") for (int k = 0; k < 2; ++k) dst[m][k] = *(const PG8_LAS bf16x8*)(lds + PG8_SA(b, h) + aoff + m * 2048 + k * 1024); } while (0)
#define PG8_LDB(dst, b, h) do { _Pragma("unroll") for (int n = 0; n < 2; ++n) _Pragma("unroll") for (int k = 0; k < 2; ++k) dst[n][k] = *(const PG8_LAS bf16x8*)(lds + PG8_SB(b, h) + boff + n * 2048 + k * 1024); } while (0)
#define PG8_MMA(ai, bj, At, Bt) do { __builtin_amdgcn_s_setprio(1); _Pragma("unroll") for (int m = 0; m < 4; ++m) _Pragma("unroll") for (int n = 0; n < 2; ++n) _Pragma("unroll") for (int k = 0; k < 2; ++k) \
        acc[ai][bj][m][n] = __builtin_amdgcn_mfma_f32_16x16x32_bf16(Bt[n][k], At[m][k], acc[ai][bj][m][n], 0, 0, 0); __builtin_amdgcn_s_setprio(0); } while (0)
#define PG8_WAIT_V(n) asm volatile("s_waitcnt vmcnt(" #n ")" ::: "memory")
#define PG8_WAIT_L(n) asm volatile("s_waitcnt lgkmcnt(" #n ")" ::: "memory")
#define PG8_BAR __builtin_amdgcn_s_barrier()
#define PG8_SCHED __builtin_amdgcn_sched_barrier(0)
    Unit cur, nxt; int ui = 0;
    if (!S.next(0, cur)) return;
    f32x4 acc[2][2][4][2];
#pragma unroll
    for (int a = 0; a < 2; ++a)
#pragma unroll
        for (int b = 0; b < 2; ++b)
#pragma unroll
            for (int m = 0; m < 4; ++m)
#pragma unroll
                for (int n = 0; n < 2; ++n) acc[a][b][m][n] = (f32x4){0.f, 0.f, 0.f, 0.f};
    bf16x8 At[4][2], B0[2][2], B1[2][2];
    const char* cA = (const char*)g.A + (size_t)cur.pm * tstep; const char* cB = (const char*)g.Bt + (size_t)cur.pn * tstep;
    S.a_ready(cur);
    if constexpr (SP2) {
        PG8_STAGE(PG8_SB(0, 0), cB, voffB); PG8_STAGE(PG8_SB(0, 1), cB + hstep, voffB); PG8_STAGE(PG8_SA(0, 0), cA, voffA); PG8_STAGE(PG8_SA(0, 1), cA + hstep, voffA);
        if (wr == 1) PG8_BAR;
        PG8_WAIT_V(2); PG8_BAR;
        PG8_STAGE(PG8_SB(1, 0), cB + kstep, voffB); PG8_STAGE(PG8_SA(1, 0), cA + kstep, voffA); PG8_STAGE(PG8_SB(1, 1), cB + hstep + kstep, voffB);
        PG8_WAIT_V(6); PG8_BAR;
    } else {
        PG8_STAGE(PG8_SB(0, 0), cB, voffB); PG8_STAGE(PG8_SA(0, 0), cA, voffA); PG8_STAGE(PG8_SB(0, 1), cB + hstep, voffB); PG8_STAGE(PG8_SA(0, 1), cA + hstep, voffA);
        if (wr == 1) PG8_BAR;
        PG8_WAIT_V(4); PG8_BAR;
        PG8_STAGE(PG8_SB(1, 0), cB + kstep, voffB); PG8_STAGE(PG8_SA(1, 0), cA + kstep, voffA); PG8_STAGE(PG8_SB(1, 1), cB + hstep + kstep, voffB);
        PG8_WAIT_V(6); PG8_BAR;
    }
    for (;;) {
        const bool has_next = S.next(ui + 1, nxt);
        const char* nA = has_next ? (const char*)g.A + (size_t)nxt.pm * tstep : cA; const char* nB = has_next ? (const char*)g.Bt + (size_t)nxt.pn * tstep : cB;
        for (int t = 0; t < nt; t += 2) {
            const bool last = (t == nt - 2);
            const char* a1 = cA + (size_t)(t + 1) * kstep;
            const char* a2 = last ? nA : cA + (size_t)(t + 2) * kstep; const char* b2 = last ? nB : cB + (size_t)(t + 2) * kstep;
            const char* a3 = a2 + kstep; const char* b3 = b2 + kstep;
            if (last && has_next) S.a_ready(nxt);
            if constexpr (SP2) {
            PG8_LDB(B0, 0, 0); PG8_LDB(B1, 0, 1); PG8_SCHED; PG8_LDA(At, 0, 0); PG8_STAGE(PG8_SA(1, 1), a1 + hstep, voffA);
            PG8_WAIT_V(8); PG8_WAIT_L(0); PG8_BAR; PG8_MMA(0, 0, At, B0); PG8_MMA(0, 1, At, B1); PG8_BAR; PG8_SCHED;
            PG8_LDA(At, 0, 1); PG8_STAGE(PG8_SB(0, 0), b2, voffB); PG8_STAGE(PG8_SB(0, 1), b2 + hstep, voffB); PG8_STAGE(PG8_SA(0, 0), a2, voffA);
            PG8_WAIT_V(8); PG8_WAIT_L(0); PG8_BAR; PG8_MMA(1, 0, At, B0); PG8_MMA(1, 1, At, B1); PG8_BAR; PG8_SCHED;
            PG8_LDB(B0, 1, 0); PG8_LDB(B1, 1, 1); PG8_SCHED; PG8_LDA(At, 1, 0); PG8_STAGE(PG8_SA(0, 1), a2 + hstep, voffA);
            PG8_WAIT_V(8); PG8_WAIT_L(0); PG8_BAR; PG8_MMA(0, 0, At, B0); PG8_MMA(0, 1, At, B1); PG8_BAR; PG8_SCHED;
            PG8_LDA(At, 1, 1); PG8_STAGE(PG8_SB(1, 0), b3, voffB); PG8_STAGE(PG8_SB(1, 1), b3 + hstep, voffB); PG8_STAGE(PG8_SA(1, 0), a3, voffA);
            PG8_WAIT_V(8); PG8_WAIT_L(0); PG8_BAR; PG8_MMA(1, 0, At, B0); PG8_MMA(1, 1, At, B1); PG8_BAR; PG8_SCHED;
            } else {
            PG8_LDB(B0, 0, 0); PG8_SCHED; PG8_LDA(At, 0, 0); PG8_STAGE(PG8_SA(1, 1), a1 + hstep, voffA);
            PG8_WAIT_L(8); PG8_BAR; PG8_WAIT_L(0); PG8_MMA(0, 0, At, B0); PG8_BAR; PG8_SCHED;
            PG8_LDB(B1, 0, 1); PG8_STAGE(PG8_SB(0, 0), b2, voffB);
            PG8_BAR; PG8_WAIT_L(0); PG8_MMA(0, 1, At, B1); PG8_BAR;
            PG8_LDA(At, 0, 1); PG8_STAGE(PG8_SA(0, 0), a2, voffA);
            PG8_BAR; PG8_WAIT_L(0); PG8_MMA(1, 0, At, B0); PG8_BAR; PG8_SCHED;
            PG8_STAGE(PG8_SB(0, 1), b2 + hstep, voffB);
            PG8_WAIT_V(6); PG8_BAR; PG8_MMA(1, 1, At, B1); PG8_BAR;
            PG8_LDB(B0, 1, 0); PG8_SCHED; PG8_LDA(At, 1, 0); PG8_STAGE(PG8_SA(0, 1), a2 + hstep, voffA);
            PG8_WAIT_L(8); PG8_BAR; PG8_WAIT_L(0); PG8_MMA(0, 0, At, B0); PG8_BAR; PG8_SCHED;
            PG8_LDB(B1, 1, 1); PG8_STAGE(PG8_SB(1, 0), b3, voffB);
            PG8_BAR; PG8_WAIT_L(0); PG8_MMA(0, 1, At, B1); PG8_BAR;
            PG8_LDA(At, 1, 1); PG8_STAGE(PG8_SA(1, 0), a3, voffA);
            PG8_BAR; PG8_WAIT_L(0); PG8_MMA(1, 0, At, B0); PG8_BAR; PG8_SCHED;
            PG8_STAGE(PG8_SB(1, 1), b3 + hstep, voffB);
            PG8_WAIT_V(6); PG8_BAR; PG8_MMA(1, 1, At, B1); PG8_BAR;
            }
        }
        if constexpr (ALIGN_EPI) { if (wr == 0) PG8_BAR; }
        if constexpr (!Epi::AFTER_DRAIN) { E(acc, cur, wr, wc, fr, fq); S.done(cur); }
        if (!has_next) break;
#pragma unroll
        for (int a = 0; a < 2; ++a)
#pragma unroll
            for (int b = 0; b < 2; ++b)
#pragma unroll
                for (int m = 0; m < 4; ++m)
#pragma unroll
                    for (int n = 0; n < 2; ++n) acc[a][b][m][n] = (f32x4){0.f, 0.f, 0.f, 0.f};
        cur = nxt; cA = nA; cB = nB; ++ui;
        if constexpr (ALIGN_EPI) { if (wr == 1) PG8_BAR; }
    }
    PG8_WAIT_V(0);
    if constexpr (!ALIGN_EPI) { if (wr == 0) PG8_BAR; }
    PG8_BAR;
    if constexpr (Epi::AFTER_DRAIN) { E.fused(acc, cur, wr, wc, fr, fq, lds, wid, lane); S.done(cur); }
#undef PG8_SA
#undef PG8_SB
#undef PG8_STAGE
#undef PG8_LDA
#undef PG8_LDB
#undef PG8_MMA
#undef PG8_WAIT_V
#undef PG8_WAIT_L
#undef PG8_BAR
#undef PG8_SCHED
}
}

#define LAS __attribute__((address_space(3)))
typedef unsigned short bf16_t;
typedef short bf16x8 __attribute__((ext_vector_type(8)));
typedef short s16x4 __attribute__((ext_vector_type(4)));
typedef float f32x4 __attribute__((ext_vector_type(4)));
typedef float f32x16 __attribute__((ext_vector_type(16)));
typedef unsigned u32x4 __attribute__((ext_vector_type(4)));
typedef unsigned u32x2 __attribute__((ext_vector_type(2)));
constexpr int NWAVES = 8, NTHREADS = 512;
constexpr int LDS_BYTES = 139264;
__device__ __forceinline__ unsigned pk_bf16(float lo, float hi) { unsigned r; asm volatile("v_cvt_pk_bf16_f32 %0, %1, %2" : "=v"(r) : "v"(lo), "v"(hi)); return r; }
__device__ __forceinline__ float bf_lo(unsigned w) { return __uint_as_float(w << 16); }
__device__ __forceinline__ float bf_hi(unsigned w) { return __uint_as_float(w & 0xffff0000u); }

constexpr size_t WS_CTL = 0, CTL_BYTES = 4096;
constexpr size_t WS_TAB = 65536;
constexpr int TABA_W = 513, TABC_W = 385, TABA_N = 12 * TABA_W, TABC_N = 24 * TABC_W, ROPE_N = 64 * 16 * 2;
constexpr size_t WS_WIN = 1u << 20;
constexpr size_t WS_WOUT = WS_WIN + (size_t)2 * NP * DM * 2;
constexpr size_t WS_H = WS_WOUT + (size_t)2 * DM * DM * 2;
constexpr size_t WS_P = WS_H + (size_t)MT * DM * 2;
constexpr size_t WS_CS = WS_P + (size_t)MT * NP * 2;
constexpr size_t WS_LSE = WS_CS + (size_t)3 * MT * 512 * 2;
constexpr size_t WS_END = WS_LSE + (size_t)3 * MT * 8 * 4;

__constant__ float INVF[16] = {1.0f, 0.5623413251903491f, 0.31622776601683794f, 0.1778279410038923f, 0.1f, 0.05623413251903491f, 0.03162277660168379f, 0.01778279410038923f,
                               0.01f, 0.005623413251903491f, 0.0031622776601683794f, 0.0017782794100389228f, 0.001f, 0.0005623413251903491f, 0.00031622776601683794f, 0.00017782794100389227f};

struct Params {
    const float* x_prompt; const float* x_sample; const float* ln_g; const float* w_in; const float* qna; const float* kna; const float* sink; const float* qnb; const float* knb;
    const float* qnc; const float* knc; const float* rel_bias; const float* w_out; float* out; unsigned char* ws;
};

__device__ __forceinline__ int t5_bucket(int rel) {
    const int n = rel < 0 ? -rel : rel;
    const int large = 8 + (n >= 15) + (n >= 27) + (n >= 50) + (n >= 91) + (n >= 166) + (n >= 305) + (n >= 559);
    return (rel > 0 ? 16 : 0) + (n < 8 ? n : large);
}
template <bool PERMUTE>
__device__ __forceinline__ void transpose_item(const float* W, int K, int N, bf16_t* WT, LAS float* scr, int item, int lane) {
    const int nblk = N / 32, kb = item / nblk, nb = item % nblk, k0 = 64 * kb, n0 = 32 * nb;
#pragma unroll 8
    for (int i = 0; i < 32; ++i) { const int kk = 2 * i + (lane >> 5); scr[kk * 33 + (lane & 31)] = W[(size_t)(k0 + kk) * N + n0 + (lane & 31)]; }
    asm volatile("s_waitcnt lgkmcnt(0)" ::: "memory");
    const int c = lane & 7;
    const int r0 = PERMUTE ? (256 * (n0 >> 8) + 128 * ((n0 >> 5) & 1) + 32 * ((n0 >> 6) & 3)) : n0;
#pragma unroll
    for (int j = 0; j < 4; ++j) { const int n = (lane >> 3) + 8 * j; const LAS float* s = scr + (8 * c) * 33 + n;
        u32x4 o; o.x = pk_bf16(s[0 * 33], s[1 * 33]); o.y = pk_bf16(s[2 * 33], s[3 * 33]); o.z = pk_bf16(s[4 * 33], s[5 * 33]); o.w = pk_bf16(s[6 * 33], s[7 * 33]);
        *(u32x4*)(WT + (size_t)(r0 + n) * K + k0 + 8 * c) = o; }
    asm volatile("s_waitcnt lgkmcnt(0)" ::: "memory");
}
__device__ __forceinline__ void prologue_phase(const Params& p, LAS unsigned char* lds, int tid, int wave, int lane) {
    LAS float* scr = (LAS float*)(lds + wave * 16384);
    const int gw = blockIdx.x * NWAVES + wave, NGW = gridDim.x * NWAVES;
    constexpr int I_IN = (DM / 64) * (NP / 32), I_OUT = (DM / 64) * (DM / 32);
    bf16_t* win = (bf16_t*)(p.ws + WS_WIN); bf16_t* wout = (bf16_t*)(p.ws + WS_WOUT);
    for (int it = gw; it < 2 * (I_IN + I_OUT); it += NGW) {
        int r = it;
        if (r < 2 * I_IN) { const int l = r / I_IN; r -= l * I_IN; transpose_item<true>(p.w_in + (size_t)l * DM * NP, DM, NP, win + (size_t)l * NP * DM, scr, r, lane); }
        else { r -= 2 * I_IN; const int l = r / I_OUT; r -= l * I_OUT; transpose_item<false>(p.w_out + (size_t)l * DM * DM, DM, DM, wout + (size_t)l * DM * DM, scr, r, lane); }
    }
    float* tab = (float*)(p.ws + WS_TAB);
    for (int i = blockIdx.x * NTHREADS + tid; i < TABA_N + TABC_N + ROPE_N / 2; i += gridDim.x * NTHREADS) {
        if (i < TABA_N) { const int h = i / TABA_W, rel = i % TABA_W - 256; tab[i] = (rel >= -128 && rel <= 128) ? p.rel_bias[t5_bucket(rel) * 36 + h] * LOG2E : -INFINITY; }
        else if (i < TABA_N + TABC_N) { const int j = i - TABA_N, gh = j / TABC_W, rel = j % TABC_W - 192, g = gh >> 3; const int dil = (g == 0) ? 1 : (g == 1 ? 4 : 16);
            tab[i] = (rel >= -64 && rel <= 64) ? p.rel_bias[t5_bucket(rel * dil) * 36 + 12 + gh] * LOG2E : -INFINITY; }
        else { const int j = i - TABA_N - TABC_N, pos = j >> 4, f = j & 15; const float ang = (float)pos * INVF[f];
            tab[TABA_N + TABC_N + 2 * j] = cosf(ang); tab[TABA_N + TABC_N + 2 * j + 1] = sinf(ang); }
    }
}
__device__ __forceinline__ void norm_phase(const float* x0, const float* x1, const float* g, bf16_t* H, int wave, int lane) {
    const int gw = blockIdx.x * NWAVES + wave, NGW = gridDim.x * NWAVES;
    for (int row = gw; row < MT; row += NGW) {
        const f32x4* xr = (const f32x4*)((row < MP) ? x0 + (size_t)row * DM : x1 + (size_t)(row - MP) * DM) + lane;
        f32x4 v[8]; float s = 0.f;
#pragma unroll
        for (int j = 0; j < 8; ++j) { v[j] = xr[64 * j]; s += (v[j][0] * v[j][0] + v[j][1] * v[j][1]) + (v[j][2] * v[j][2] + v[j][3] * v[j][3]); }
#pragma unroll
        for (int o = 1; o < 64; o <<= 1) s += __shfl_xor(s, o);
        const float rs = 1.0f / sqrtf(s * (1.0f / DM) + RMS_EPS);
        u32x2* o8 = (u32x2*)(H + (size_t)row * DM) + lane;
#pragma unroll
        for (int j = 0; j < 8; ++j) { const f32x4 gv = ((const f32x4*)g)[lane + 64 * j]; u32x2 o;
            o.x = pk_bf16(v[j][0] * rs * gv[0], v[j][1] * rs * gv[1]); o.y = pk_bf16(v[j][2] * rs * gv[2], v[j][3] * rs * gv[3]); o8[64 * j] = o; }
    }
}

namespace att {
constexpr int KP = 144, VP = 192, KBUF = 64 * KP, VBUF = 64 * VP, BUFB = KBUF + VBUF;
constexpr int L_TAB = 2 * BUFB, L_SLOT = L_TAB + (TABA_N + TABC_N) * 4;
static_assert(L_SLOT + 64 <= LDS_BYTES, "attention LDS map");
constexpr int N_BS = 768, N_BP = 192, N_A = 960, N_C = 1920, N_UNITS = N_BS + N_BP + N_A + N_C;
constexpr float THR = 5.0f;
typedef short v4i16_t __attribute__((ext_vector_type(4)));
__device__ __forceinline__ s16x4 vtr(const LAS unsigned char* p) { return __builtin_bit_cast(s16x4, __builtin_amdgcn_ds_read_tr16_b64_v4i16((LAS v4i16_t*)p)); }
#define MFMA32(a, b, c) __builtin_amdgcn_mfma_f32_32x32x16_bf16((a), (b), (c), 0, 0, 0)

struct UnitP { int rowbase, dil, rho, i0, t_lo, t_hi, qcol, kcol, vcol, gcol, ocol, tabidx, g, kvi; };

__device__ __forceinline__ void softmax_step(f32x16& p0, f32x16& p1, float& m, float& l, f32x16& o0, f32x16& o1) {
    float a = fmaxf(fmaxf(p0[0], p0[1]), p1[0]), b = fmaxf(fmaxf(p0[2], p0[3]), p1[1]); a = fmaxf(fmaxf(a, p1[2]), p1[3]);
#pragma unroll
    for (int r = 4; r < 16; r += 4) { a = fmaxf(fmaxf(a, p0[r]), p0[r + 1]); b = fmaxf(fmaxf(b, p0[r + 2]), p0[r + 3]); a = fmaxf(fmaxf(a, p1[r]), p1[r + 1]); b = fmaxf(fmaxf(b, p1[r + 2]), p1[r + 3]); }
    float rm = fmaxf(a, b);
    { auto rr = __builtin_amdgcn_permlane32_swap(__float_as_uint(rm), __float_as_uint(rm), false, false); rm = fmaxf(__uint_as_float(rr[0]), __uint_as_float(rr[1])); }
    if (__any(rm > m + THR)) { const float mn = fmaxf(m, rm), al = __builtin_amdgcn_exp2f(m - mn); m = mn; l *= al; o0 = o0 * al; o1 = o1 * al; }
    float ls0 = 0.f, ls1 = 0.f;
#pragma unroll
    for (int r = 0; r < 16; ++r) { p0[r] = __builtin_amdgcn_exp2f(p0[r] - m); p1[r] = __builtin_amdgcn_exp2f(p1[r] - m); ls0 += p0[r]; ls1 += p1[r]; }
    l += ls0 + ls1;
}
__device__ __forceinline__ bf16x8 pack8(const f32x16& x, int s) {
    u32x4 w; w.x = pk_bf16(x[8 * s], x[8 * s + 1]); w.y = pk_bf16(x[8 * s + 2], x[8 * s + 3]); w.z = pk_bf16(x[8 * s + 4], x[8 * s + 5]); w.w = pk_bf16(x[8 * s + 6], x[8 * s + 7]);
    return __builtin_bit_cast(bf16x8, w);
}
template <int MODE>
__device__ __forceinline__ void store_block(const Params& p, const UnitP& u, const f32x16& o0, const f32x16& o1, float m, float l, float m_sink, size_t qrow, int hq, int hi) {
    const bf16_t* __restrict__ P = (const bf16_t*)(p.ws + WS_P);
    float lt; { auto rr = __builtin_amdgcn_permlane32_swap(__float_as_uint(l), __float_as_uint(l), false, false); lt = __uint_as_float(rr[0]) + __uint_as_float(rr[1]); }
    if (MODE == 0) lt += __builtin_amdgcn_exp2f(m_sink - m);
    const float inv = __builtin_amdgcn_rcpf(lt);
    if (MODE != 2) {
        bf16_t* mix = (bf16_t*)(p.ws + WS_H) + qrow * DM + u.ocol + hq * 64 + 4 * hi;
        const bf16_t* gp = P + qrow * NP + u.gcol + hq * 64 + 4 * hi;
#pragma unroll
        for (int g = 0; g < 4; ++g) {
            const u32x2 g0 = *(const u32x2*)(gp + 8 * g), g1 = *(const u32x2*)(gp + 32 + 8 * g); u32x2 w0, w1;
            w0.x = pk_bf16(o0[4 * g] * inv * bf_lo(g0.x), o0[4 * g + 1] * inv * bf_hi(g0.x)); w0.y = pk_bf16(o0[4 * g + 2] * inv * bf_lo(g0.y), o0[4 * g + 3] * inv * bf_hi(g0.y));
            w1.x = pk_bf16(o1[4 * g] * inv * bf_lo(g1.x), o1[4 * g + 1] * inv * bf_hi(g1.x)); w1.y = pk_bf16(o1[4 * g + 2] * inv * bf_lo(g1.y), o1[4 * g + 3] * inv * bf_hi(g1.y));
            *(u32x2*)(mix + 8 * g) = w0; *(u32x2*)(mix + 32 + 8 * g) = w1;
        }
    } else {
        bf16_t* cs = (bf16_t*)(p.ws + WS_CS) + ((size_t)u.g * MT + qrow) * 512 + (u.kvi * 4 + hq) * 64 + 4 * hi;
#pragma unroll
        for (int g = 0; g < 4; ++g) { u32x2 w0, w1;
            w0.x = pk_bf16(o0[4 * g] * inv, o0[4 * g + 1] * inv); w0.y = pk_bf16(o0[4 * g + 2] * inv, o0[4 * g + 3] * inv);
            w1.x = pk_bf16(o1[4 * g] * inv, o1[4 * g + 1] * inv); w1.y = pk_bf16(o1[4 * g + 2] * inv, o1[4 * g + 3] * inv);
            *(u32x2*)(cs + 8 * g) = w0; *(u32x2*)(cs + 32 + 8 * g) = w1; }
        if (hi == 0) ((float*)(p.ws + WS_LSE))[((size_t)u.g * MT + qrow) * 8 + u.kvi * 4 + hq] = m + __builtin_amdgcn_logf(lt);
    }
}
template <int MODE>
__device__ __forceinline__ void unit(LAS unsigned char* lds, const Params& p, const UnitP& u, int tid, int wave, int lane) {
    const bf16_t* __restrict__ P = (const bf16_t*)(p.ws + WS_P);
    const int r32 = lane & 31, hi = lane >> 5, hq = wave >> 1, sub = wave & 1;
    const int iqa = u.i0 + 64 * sub + r32;
    const size_t qrow_a = (size_t)(u.rowbase + u.rho + u.dil * iqa), qrow_b = qrow_a + (size_t)(32 * u.dil);
    constexpr int W = (MODE == 0) ? 128 : 64, TW = (MODE == 0) ? TABA_W : TABC_W, TC = (MODE == 0) ? 256 : 192;
    const int kk = tid >> 3, ch = tid & 7;
    const bf16_t* kg = P + (size_t)(u.rowbase + u.rho + u.dil * kk) * NP + u.kcol + ch * 8;
    const bf16_t* vg = P + (size_t)(u.rowbase + u.rho + u.dil * kk) * NP + u.vcol + ch * 8;
    const size_t tstep = (size_t)64 * u.dil * NP;
    u32x4 kreg = *(const u32x4*)(kg + (size_t)u.t_lo * tstep), vreg = *(const u32x4*)(vg + (size_t)u.t_lo * tstep);
    bf16x8 qa[4], qb[4];
#pragma unroll
    for (int ds = 0; ds < 4; ++ds) { qa[ds] = *(const bf16x8*)(P + qrow_a * NP + u.qcol + hq * 64 + ds * 16 + hi * 8); qb[ds] = *(const bf16x8*)(P + qrow_b * NP + u.qcol + hq * 64 + ds * 16 + hi * 8); }
    LAS unsigned char* kst = lds + kk * KP + ch * 16; LAS unsigned char* vst = lds + KBUF + kk * VP + ch * 16;
    *(LAS u32x4*)kst = kreg; *(LAS u32x4*)vst = vreg;
    asm volatile("" :: "v"(qa[0]), "v"(qa[1]), "v"(qa[2]), "v"(qa[3]), "v"(qb[0]), "v"(qb[1]), "v"(qb[2]), "v"(qb[3]));
    const LAS unsigned char* krd = lds + r32 * KP + hi * 16;
    const LAS unsigned char* vrd = lds + KBUF + (4 * hi + ((lane & 15) >> 2)) * VP + ((lane >> 4) & 1) * 32 + (lane & 3) * 8;
    const LAS float* btab = (const LAS float*)(lds + L_TAB) + u.tabidx + hq * TW + TC;
    float m_sink = -1e30f;
    if (MODE == 0) m_sink = p.sink[u.g * 12 + u.kvi * 4 + hq] * LOG2E;
    float ma = m_sink, mb = m_sink, la = 0.f, lb = 0.f;
    f32x16 oa0 = {}, oa1 = {}, ob0 = {}, ob1 = {};
    int wt_lo = u.t_lo, wt_hi = u.t_hi;
    if (MODE != 1) { const int c = (u.i0 >> 6) + sub; wt_lo = c - W / 64 > wt_lo ? c - W / 64 : wt_lo; wt_hi = c + W / 64 < wt_hi ? c + W / 64 : wt_hi; }
    for (int t = u.t_lo; t <= u.t_hi; ++t) {
        const int boff = ((t - u.t_lo) & 1) * BUFB;
        __syncthreads();
        if (t < u.t_hi) { kreg = *(const u32x4*)(kg + (size_t)(t + 1) * tstep); vreg = *(const u32x4*)(vg + (size_t)(t + 1) * tstep); }
        if (MODE == 1 || (t >= wt_lo && t <= wt_hi)) {
            f32x16 pa0 = {}, pa1 = {}, pb0 = {}, pb1 = {};
#pragma unroll
            for (int ds = 0; ds < 4; ++ds) {
                const bf16x8 k0 = *(const LAS bf16x8*)(krd + boff + ds * 32), k1 = *(const LAS bf16x8*)(krd + boff + 32 * KP + ds * 32);
                pa0 = MFMA32(k0, qa[ds], pa0); pa1 = MFMA32(k1, qa[ds], pa1); pb0 = MFMA32(k0, qb[ds], pb0); pb1 = MFMA32(k1, qb[ds], pb1);
            }
            __builtin_amdgcn_sched_barrier(0);
            if (MODE != 1) {
                const LAS float* bt = btab + (64 * t - iqa + 4 * hi);
#pragma unroll
                for (int r = 0; r < 16; ++r) { const int o = (r & 3) + 8 * (r >> 2);
                    pa0[r] += bt[o]; pa1[r] += bt[o + 32]; pb0[r] += bt[o - 32]; pb1[r] += bt[o]; }
            }
            softmax_step(pa0, pa1, ma, la, oa0, oa1);
            softmax_step(pb0, pb1, mb, lb, ob0, ob1);
            __builtin_amdgcn_sched_barrier(0);
#pragma unroll
            for (int s = 0; s < 4; ++s) {
                const bf16x8 xa = (s < 2) ? pack8(pa0, s & 1) : pack8(pa1, s & 1), xb = (s < 2) ? pack8(pb0, s & 1) : pack8(pb1, s & 1);
                const LAS unsigned char* vb = vrd + boff + s * 16 * VP;
                const s16x4 a0 = vtr(vb), a1 = vtr(vb + 8 * VP), b0 = vtr(vb + 64), b1 = vtr(vb + 8 * VP + 64);
                const bf16x8 vf0 = __builtin_shufflevector(a0, a1, 0, 1, 2, 3, 4, 5, 6, 7), vf1 = __builtin_shufflevector(b0, b1, 0, 1, 2, 3, 4, 5, 6, 7);
                oa0 = MFMA32(vf0, xa, oa0); oa1 = MFMA32(vf1, xa, oa1); ob0 = MFMA32(vf0, xb, ob0); ob1 = MFMA32(vf1, xb, ob1);
                __builtin_amdgcn_sched_barrier(0);
            }
        }
        if (t < u.t_hi) { *(LAS u32x4*)(kst + (BUFB - boff)) = kreg; *(LAS u32x4*)(vst + (BUFB - boff)) = vreg; }
    }
    store_block<MODE>(p, u, oa0, oa1, ma, la, m_sink, qrow_a, hq, hi);
    store_block<MODE>(p, u, ob0, ob1, mb, lb, m_sink, qrow_b, hq, hi);
}

__device__ __forceinline__ void seqblk_decode(int sb, int& rowbase, int& S, int& blk) {
    if (sb < 256) { rowbase = MP + (sb >> 5) * 4096; S = 4096; blk = sb & 31; } else { sb -= 256; rowbase = (sb >> 4) * 2048; S = 2048; blk = sb & 15; }
}
__device__ __forceinline__ void phase(LAS unsigned char* lds, const Params& p, int layer, int cslot, int tid, int wave, int lane) {
    { const float* gt = (const float*)(p.ws + WS_TAB); LAS float* lt = (LAS float*)(lds + L_TAB);
      for (int i = tid; i < TABA_N + TABC_N; i += NTHREADS) lt[i] = gt[i]; }
    unsigned* ctr = (unsigned*)(p.ws + WS_CTL) + 64 * cslot;
    volatile LAS int* slot = (volatile LAS int*)(lds + L_SLOT);
    int nxt = 0;
    if (tid == 0) { nxt = (int)atomicAdd(ctr, 1u); *slot = nxt; }
    __syncthreads();
    int un = *slot;
    while (un < N_UNITS) {
        if (tid == 0) nxt = (int)atomicAdd(ctr, 1u);
        UnitP u; u.dil = 1; u.rho = 0; u.g = 0; u.kvi = 0; u.tabidx = 0; u.gcol = 0; u.ocol = 0;
        if (un < N_BS + N_BP) {
            int b, kvh, blk, S;
            if (un < N_BS) { b = un / 96; const int rem = un % 96; kvh = rem >> 5; blk = rem & 31; u.rowbase = MP + b * 4096; S = 4096; }
            else { const int v = un - N_BS; b = v / 48; const int rem = v % 48; kvh = rem >> 4; blk = rem & 15; u.rowbase = b * 2048; S = 2048; }
            u.i0 = blk * 128; u.t_lo = 0; u.t_hi = S / 64 - 1; u.qcol = C_QB + kvh * 256; u.kcol = C_KB + kvh * 64; u.vcol = C_VB + kvh * 64; u.gcol = C_GB + kvh * 256; u.ocol = 768 + kvh * 256;
            unit<1>(lds, p, u, tid, wave, lane);
        } else if (un < N_BS + N_BP + N_A) {
            const int v = un - (N_BS + N_BP), sb = v / 3, kvh = v % 3; int S, blk; seqblk_decode(sb, u.rowbase, S, blk);
            u.i0 = blk * 128; u.t_lo = 2 * blk - 2 < 0 ? 0 : 2 * blk - 2; u.t_hi = 2 * blk + 3 > S / 64 - 1 ? S / 64 - 1 : 2 * blk + 3;
            u.qcol = C_QA + kvh * 256; u.kcol = C_KA + kvh * 64; u.vcol = C_VA + kvh * 64; u.gcol = C_GA + kvh * 256; u.ocol = kvh * 256; u.tabidx = kvh * 4 * TABA_W; u.g = layer; u.kvi = kvh;
            unit<0>(lds, p, u, tid, wave, lane);
        } else {
            const int v = un - (N_BS + N_BP + N_A), g = v / 640, r = v % 640, sb = r >> 1, kvi = r & 1; int S, blk; seqblk_decode(sb, u.rowbase, S, blk);
            const int dsh = 2 * g, nb = (S >> dsh) >> 7;
            u.dil = 1 << dsh; u.rho = blk / nb; const int lb = blk % nb; u.i0 = lb * 128; u.t_lo = 2 * lb - 1 < 0 ? 0 : 2 * lb - 1; u.t_hi = 2 * lb + 2 > 2 * nb - 1 ? 2 * nb - 1 : 2 * lb + 2;
            u.qcol = C_QC + (g * 8 + kvi * 4) * 64; u.kcol = C_KC + (g * 2 + kvi) * 64; u.vcol = C_VC + (g * 2 + kvi) * 64; u.tabidx = TABA_N + (g * 8 + kvi * 4) * TABC_W; u.g = g; u.kvi = kvi;
            unit<2>(lds, p, u, tid, wave, lane);
        }
        __syncthreads();
        if (tid == 0) *slot = nxt;
        __syncthreads();
        un = *slot;
    }
}
__device__ __forceinline__ void combine_phase(const Params& p, int tid) {
    const bf16_t* cs = (const bf16_t*)(p.ws + WS_CS); const float* lse = (const float*)(p.ws + WS_LSE);
    const bf16_t* P = (const bf16_t*)(p.ws + WS_P); bf16_t* mix = (bf16_t*)(p.ws + WS_H);
    for (size_t i = (size_t)blockIdx.x * NTHREADS + tid; i < (size_t)MT * 64; i += (size_t)gridDim.x * NTHREADS) {
        const size_t row = i >> 6; const int hc = (int)(i >> 3) & 7, chk = (int)i & 7;
        const float l0 = lse[row * 8 + hc], l1 = lse[((size_t)MT + row) * 8 + hc], l2 = lse[((size_t)2 * MT + row) * 8 + hc];
        const float mx = fmaxf(l0, fmaxf(l1, l2));
        float w0 = __builtin_amdgcn_exp2f(l0 - mx), w1 = __builtin_amdgcn_exp2f(l1 - mx), w2 = __builtin_amdgcn_exp2f(l2 - mx);
        const float inv = 1.0f / (w0 + w1 + w2); w0 *= inv; w1 *= inv; w2 *= inv;
        const u32x4 a = *(const u32x4*)(cs + row * 512 + hc * 64 + chk * 8), b = *(const u32x4*)(cs + ((size_t)MT + row) * 512 + hc * 64 + chk * 8),
                    c = *(const u32x4*)(cs + ((size_t)2 * MT + row) * 512 + hc * 64 + chk * 8), gt = *(const u32x4*)(P + row * NP + C_GC + hc * 64 + chk * 8);
        u32x4 o;
#pragma unroll
        for (int k = 0; k < 4; ++k) {
            const float lo = (w0 * bf_lo(a[k]) + w1 * bf_lo(b[k]) + w2 * bf_lo(c[k])) * bf_lo(gt[k]), hi = (w0 * bf_hi(a[k]) + w1 * bf_hi(b[k]) + w2 * bf_hi(c[k])) * bf_hi(gt[k]);
            o[k] = pk_bf16(lo, hi);
        }
        *(u32x4*)(mix + row * DM + 1536 + hc * 64 + chk * 8) = o;
    }
}
}

typedef const __attribute__((address_space(4))) Params* KParamsPtr;
__device__ __forceinline__ Params fresh_params() {
#if defined(__HIP_DEVICE_COMPILE__)
    KParamsPtr pp = (KParamsPtr)__builtin_amdgcn_kernarg_segment_ptr(); asm volatile("" : "+s"(pp)); Params r;
    r.x_prompt = pp->x_prompt; r.x_sample = pp->x_sample; r.ln_g = pp->ln_g; r.w_in = pp->w_in; r.qna = pp->qna; r.kna = pp->kna; r.sink = pp->sink; r.qnb = pp->qnb; r.knb = pp->knb;
    r.qnc = pp->qnc; r.knc = pp->knc; r.rel_bias = pp->rel_bias; r.w_out = pp->w_out; r.out = pp->out; r.ws = pp->ws; return r;
#else
    return Params{};
#endif
}
#define PHASE_IDS() int tid_l = threadIdx.x; asm volatile("" : "+v"(tid_l)); const int tid = tid_l, lane = tid & 63, wave = __builtin_amdgcn_readfirstlane(tid >> 6); (void)lane; (void)wave
__global__ void __launch_bounds__(NTHREADS, 2) fwd_megakernel(Params p_unused) {
    extern __shared__ __attribute__((aligned(16))) unsigned char lds_raw[];
    LAS unsigned char* lds = (LAS unsigned char*)lds_raw;
#ifndef NO_PRO
    { const Params p = fresh_params(); PHASE_IDS(); prologue_phase(p, lds, tid, wave, lane); }
#endif
    for (int layer = 0; layer < 2; ++layer) {
        asm volatile("" : "+s"(layer));
#ifndef NO_NORM
        { const Params p = fresh_params(); PHASE_IDS();
          const float* x0 = layer == 0 ? p.x_prompt : p.out; const float* x1 = layer == 0 ? p.x_sample : p.out + (size_t)MP * DM;
          norm_phase(x0, x1, p.ln_g + layer * DM, (bf16_t*)(p.ws + WS_H), wave, lane); }
#endif
        cg::this_grid().sync();
#ifndef NO_G1
        { const Params p = fresh_params();
          pg8::Gemm g{(const bf16_t*)(p.ws + WS_H), (const bf16_t*)(p.ws + WS_WIN) + (size_t)layer * NP * DM, MT, NP, DM}; pg8::StaticOrder S; S.init(MT, NP, (int)gridDim.x, (int)blockIdx.x);
          pg8::EpiProj E{(bf16_t*)(p.ws + WS_P), p.qna + layer * 64, p.kna + layer * 64, p.qnb + layer * 64, p.knb + layer * 64, p.qnc + layer * 64, p.knc + layer * 64, (const float*)(p.ws + WS_TAB) + TABA_N + TABC_N};
          pg8::gemm_phase<pg8::EpiProj, pg8::StaticOrder, true, true>(lds, g, S, E);
#if defined(REP_G1)
          pg8::gemm_phase<pg8::EpiProj, pg8::StaticOrder, true, true>(lds, g, S, E);
#endif
        }
#endif
        cg::this_grid().sync();
#ifndef NO_ATT
        { const Params p = fresh_params(); PHASE_IDS(); att::phase(lds, p, layer, layer, tid, wave, lane); }
#if defined(REP_ATT)
        cg::this_grid().sync();
        { const Params p = fresh_params(); PHASE_IDS(); att::phase(lds, p, layer, layer + 2, tid, wave, lane); }
#endif
#endif
        cg::this_grid().sync();
#ifndef NO_CMB
        { const Params p = fresh_params(); PHASE_IDS(); att::combine_phase(p, tid); }
#endif
        cg::this_grid().sync();
#ifndef NO_G2
        { const Params p = fresh_params();
          const float* x0 = layer == 0 ? p.x_prompt : p.out; const float* x1 = layer == 0 ? p.x_sample : p.out + (size_t)MP * DM;
          pg8::Gemm g{(const bf16_t*)(p.ws + WS_H), (const bf16_t*)(p.ws + WS_WOUT) + (size_t)layer * DM * DM, MT, DM, DM}; pg8::StaticOrder S; S.init(MT, DM, (int)gridDim.x, (int)blockIdx.x);
          pg8::EpiRes E{x0, x1, p.out};
          pg8::gemm_phase<pg8::EpiRes, pg8::StaticOrder, true, true>(lds, g, S, E); }
#endif
        if (layer == 0) cg::this_grid().sync();
    }
}

extern "C" void kernel_launch(void* const* d_in, const int* in_sizes, int n_in, void* d_out, int out_size, void* d_ws, size_t ws_size, hipStream_t stream) {
    static int grid_blocks = 0;
    if (grid_blocks == 0) {
        if (n_in != 13 || out_size != MT * DM || ws_size < WS_END) { fprintf(stderr, "kernel_launch: unexpected shapes (n_in %d, out %d, ws %zu < %zu)\n", n_in, out_size, ws_size, (size_t)WS_END); grid_blocks = -1; return; }
        int dev = 0, cus = 0, per_cu = 0;
        hipGetDevice(&dev); hipDeviceGetAttribute(&cus, hipDeviceAttributeMultiprocessorCount, dev);
        hipFuncSetAttribute((const void*)fwd_megakernel, hipFuncAttributeMaxDynamicSharedMemorySize, LDS_BYTES);
        hipOccupancyMaxActiveBlocksPerMultiprocessor(&per_cu, (const void*)fwd_megakernel, NTHREADS, LDS_BYTES);
        if (per_cu < 1) { fprintf(stderr, "kernel_launch: occupancy query says %d blocks/CU\n", per_cu); per_cu = 1; }
        (void)hipGetLastError();
        grid_blocks = cus * 1;
    }
    if (grid_blocks < 0) return;
    hipMemsetAsync((char*)d_ws + WS_CTL, 0, CTL_BYTES, stream);
    Params p{};
    p.x_prompt = (const float*)d_in[0]; p.x_sample = (const float*)d_in[1]; p.ln_g = (const float*)d_in[2]; p.w_in = (const float*)d_in[3]; p.qna = (const float*)d_in[4]; p.kna = (const float*)d_in[5];
    p.sink = (const float*)d_in[6]; p.qnb = (const float*)d_in[7]; p.knb = (const float*)d_in[8]; p.qnc = (const float*)d_in[9]; p.knc = (const float*)d_in[10]; p.rel_bias = (const float*)d_in[11];
    p.w_out = (const float*)d_in[12]; p.out = (float*)d_out; p.ws = (unsigned char*)d_ws;
    void* args[] = {&p};
    hipError_t e = hipLaunchCooperativeKernel((const void*)fwd_megakernel, dim3(grid_blocks), dim3(NTHREADS), args, LDS_BYTES, stream);
    if (e != hipSuccess) fprintf(stderr, "cooperative launch failed: %s (grid %d)\n", hipGetErrorString(e), grid_blocks);
}
```

```cpp
#include <hip/hip_runtime.h>
#include <hip/hip_cooperative_groups.h>
#include <cstdio>
#include <cstdint>
namespace cg = cooperative_groups;

constexpr int DM = 2048, NP = 6656, MP = 8192, MS = 32768, MT = MP + MS;
constexpr int C_QA = 0, C_KA = 768, C_VA = 960, C_GA = 1152, C_QB = 1920, C_KB = 2688, C_VB = 2880, C_GB = 3072, C_QC = 3840, C_KC = 5376, C_VC = 5760, C_GC = 6144;
constexpr float QSCALE = 0.125f * 1.4426950408889634f;
constexpr float LOG2E = 1.4426950408889634f;
constexpr float RMS_EPS = 1e-6f;

namespace pg8 {
#define PG8_LAS __attribute__((address_space(3)))
typedef unsigned short bf16_t;
typedef short bf16x8 __attribute__((ext_vector_type(8)));
typedef float f32x4 __attribute__((ext_vector_type(4)));
typedef unsigned u32x4 __attribute__((ext_vector_type(4)));
constexpr int BM = 256, BK = 64, HALF = 128, HTB = HALF * BK * 2  , STAGE_BYTES = 8 * HTB, NXCD = 8, WGM = 8;

__host__ __device__ __forceinline__ int lds_byte(int r, int c) { const int st = (r >> 4) * 2 + (c >> 5), rr = r & 15, cc = c & 31, ob = rr * 64 + cc * 2; return st * 1024 + (ob ^ (((ob >> 9) & 1) << 5)); }
__host__ __device__ __forceinline__ void stage_rc(int b, int& R, int& C) { const int st = b / 1024, sb = b % 1024, swz = sb ^ (((sb >> 9) & 1) << 5); R = (st >> 1) * 16 + swz / 64; C = (st & 1) * 32 + (swz % 64) / 2; }
__host__ __device__ __forceinline__ int perm32(int rho) { const int n = rho >> 4, i = rho & 15; return 8 * (i >> 2) + 4 * n + (i & 3); }

struct Unit { int pm, pn; };
struct Gemm { const bf16_t* A; const bf16_t* Bt; int M, N, K; };

struct StaticOrder {
    int nM, nN, nwg, G, c;
    __host__ __device__ void init(int M, int N, int G_, int c_) { nM = M / BM; nN = N / BM; nwg = nM * nN; G = G_; c = c_; }
    __host__ __device__ bool next(int i, Unit& u) const {
        const long L = (long)i * G + c; if (L >= nwg) return false;
        int wgid = (int)L; { const int q = nwg / NXCD, r = nwg % NXCD, xcd = wgid % NXCD, off = wgid / NXCD; wgid = (xcd < r ? xcd * (q + 1) : r * (q + 1) + (xcd - r) * q) + off; }
        const int nig = WGM * nN, gid = wgid / nig, fm = gid * WGM, gsz = (nM - fm) < WGM ? (nM - fm) : WGM;
        u.pm = fm + ((wgid % nig) % gsz); u.pn = (wgid % nig) / gsz; return true;
    }
    __device__ __forceinline__ void a_ready(const Unit&) const {}
    __device__ __forceinline__ void done(const Unit&) const {}
};

__device__ __forceinline__ unsigned cvt_pk_bf16(float lo, float hi) { unsigned r; asm volatile("v_cvt_pk_bf16_f32 %0, %1, %2" : "=v"(r) : "v"(lo), "v"(hi)); return r; }
typedef float f32x2e __attribute__((ext_vector_type(2)));
struct EpiProj {
    static constexpr bool PERM = true, AFTER_DRAIN = false;
    bf16_t* P; const float *qna, *kna, *qnb, *knb, *qnc, *knc; const float* rope;
    __device__ __forceinline__ void operator()(const f32x4 (&acc)[2][2][4][2], const Unit& u, int wr, int wc, int fr, int fq) const {
        const int hd = u.pn * 4 + wc;
        int type; const float* w = qna; float qs = 1.f;
        if (hd < 12) { type = 2; w = qna; qs = QSCALE; } else if (hd < 15) { type = 2; w = kna; } else if (hd < 18) { type = 0; } else if (hd < 30) { type = 1; }
        else if (hd < 42) { type = 3; w = qnb; qs = QSCALE; } else if (hd < 45) { type = 3; w = knb; } else if (hd < 48) { type = 0; } else if (hd < 60) { type = 1; }
        else if (hd < 84) { type = 2; w = qnc; qs = QSCALE; } else if (hd < 90) { type = 2; w = knc; } else if (hd < 96) { type = 0; } else { type = 1; }
        const int row0 = u.pm * BM + wr * 64 + fr;
        bf16_t* base = P + (size_t)row0 * NP + hd * 64 + 8 * fq;
        if (type == 0) {
#pragma unroll
            for (int ai = 0; ai < 2; ++ai)
#pragma unroll
                for (int m = 0; m < 4; ++m) { bf16_t* rowp = base + (size_t)(ai * HALF + m * 16) * NP;
#pragma unroll
                    for (int bj = 0; bj < 2; ++bj) { const f32x4 v0 = acc[ai][bj][m][0], v1 = acc[ai][bj][m][1]; u32x4 o;
                        o.x = cvt_pk_bf16(v0[0], v0[1]); o.y = cvt_pk_bf16(v0[2], v0[3]); o.z = cvt_pk_bf16(v1[0], v1[1]); o.w = cvt_pk_bf16(v1[2], v1[3]);
                        *(u32x4*)(rowp + bj * 32) = o; } }
        } else if (type == 1) {
#pragma unroll
            for (int ai = 0; ai < 2; ++ai)
#pragma unroll
                for (int m = 0; m < 4; ++m) { bf16_t* rowp = base + (size_t)(ai * HALF + m * 16) * NP;
#pragma unroll
                    for (int bj = 0; bj < 2; ++bj) { f32x4 v[2] = {acc[ai][bj][m][0], acc[ai][bj][m][1]};
#pragma unroll
                        for (int n = 0; n < 2; ++n)
#pragma unroll
                            for (int e = 0; e < 4; ++e) { const float g = v[n][e]; v[n][e] = g * __builtin_amdgcn_rcpf(1.f + __builtin_amdgcn_exp2f(-g * LOG2E)); }
                        u32x4 o; o.x = cvt_pk_bf16(v[0][0], v[0][1]); o.y = cvt_pk_bf16(v[0][2], v[0][3]); o.z = cvt_pk_bf16(v[1][0], v[1][1]); o.w = cvt_pk_bf16(v[1][2], v[1][3]);
                        *(u32x4*)(rowp + bj * 32) = o; } }
        } else {
            f32x4 wv[2][2];
#pragma unroll
            for (int bj = 0; bj < 2; ++bj)
#pragma unroll
                for (int n = 0; n < 2; ++n) wv[bj][n] = *(const f32x4*)(w + 32 * bj + 8 * fq + 4 * n);
            const float sgn = (fq < 2) ? -1.f : 1.f;
#pragma unroll
            for (int ai = 0; ai < 2; ++ai)
#pragma unroll
                for (int m = 0; m < 4; ++m) { bf16_t* rowp = base + (size_t)(ai * HALF + m * 16) * NP;
                    f32x4 v[2][2]; float ss = 0.f;
#pragma unroll
                    for (int bj = 0; bj < 2; ++bj)
#pragma unroll
                        for (int n = 0; n < 2; ++n) { v[bj][n] = acc[ai][bj][m][n]; const f32x4 x = v[bj][n]; ss += (x[0] * x[0] + x[1] * x[1]) + (x[2] * x[2] + x[3] * x[3]); }
                    ss += __shfl_xor(ss, 16); ss += __shfl_xor(ss, 32);
                    const float rs = __builtin_amdgcn_rsqf(ss * (1.0f / 64.0f) + RMS_EPS);
#pragma unroll
                    for (int bj = 0; bj < 2; ++bj)
#pragma unroll
                        for (int n = 0; n < 2; ++n) v[bj][n] = v[bj][n] * rs * wv[bj][n];
                    if (type == 3) {
                        const int r = row0 + ai * HALF + m * 16, t = r & ((r < MP) ? 2047 : 4095);
#pragma unroll
                        for (int bj = 0; bj < 2; ++bj) { const int pos = bj ? (t & 63) : (t >> 6);
#pragma unroll
                            for (int n = 0; n < 2; ++n) { const float* tp = rope + (size_t)(pos * 16 + 8 * (fq & 1) + 4 * n) * 2;
                                const f32x4 cs0 = *(const f32x4*)tp, cs1 = *(const f32x4*)(tp + 4); const f32x4 x = v[bj][n]; f32x4 pr;
                                pr[0] = __shfl_xor(x[0], 32); pr[1] = __shfl_xor(x[1], 32); pr[2] = __shfl_xor(x[2], 32); pr[3] = __shfl_xor(x[3], 32);
                                f32x4 y; y[0] = x[0] * cs0[0] + sgn * pr[0] * cs0[1]; y[1] = x[1] * cs0[2] + sgn * pr[1] * cs0[3];
                                y[2] = x[2] * cs1[0] + sgn * pr[2] * cs1[1]; y[3] = x[3] * cs1[2] + sgn * pr[3] * cs1[3]; v[bj][n] = y; } }
                    }
#pragma unroll
                    for (int bj = 0; bj < 2; ++bj) { const f32x4 v0 = v[bj][0] * qs, v1 = v[bj][1] * qs; u32x4 o;
                        o.x = cvt_pk_bf16(v0[0], v0[1]); o.y = cvt_pk_bf16(v0[2], v0[3]); o.z = cvt_pk_bf16(v1[0], v1[1]); o.w = cvt_pk_bf16(v1[2], v1[3]);
                        *(u32x4*)(rowp + bj * 32) = o; } }
        }
    }
};
struct EpiRes {
    static constexpr bool PERM = true, AFTER_DRAIN = false;
    const float* x0; const float* x1; float* out;
    __device__ __forceinline__ void operator()(const f32x4 (&acc)[2][2][4][2], const Unit& u, int wr, int wc, int fr, int fq) const {
        const int row0 = u.pm * BM + wr * 64 + fr, col0 = u.pn * BM + wc * 32 + 8 * fq;
        const float* xb = (row0 < MP) ? x0 + (size_t)row0 * DM : x1 + (size_t)(row0 - MP) * DM;
        float* ob = out + (size_t)row0 * DM;
#pragma unroll
        for (int ai = 0; ai < 2; ++ai)
#pragma unroll
            for (int m = 0; m < 4; ++m) { const size_t off = (size_t)(ai * HALF + m * 16) * DM + col0;
#pragma unroll
                for (int bj = 0; bj < 2; ++bj) { const f32x4 a0 = *(const f32x4*)(xb + off + bj * HALF), a1 = *(const f32x4*)(xb + off + bj * HALF + 4);
                    *(f32x4*)(ob + off + bj * HALF) = a0 + acc[ai][bj][m][0]; *(f32x4*)(ob + off + bj * HALF + 4) = a1 + acc[ai][bj][m][1]; } }
    }
};

template <class Epi, class Sched, bool ALIGN_EPI = false, bool SP2 = false>
__device__ __forceinline__ void gemm_phase(PG8_LAS unsigned char* lds, const Gemm g, const Sched& S, const Epi& E) {
    int tid_l = threadIdx.x; asm volatile("" : "+v"(tid_l));
    const int tid = tid_l, wid = __builtin_amdgcn_readfirstlane(tid >> 6), lane = tid & 63, wr = wid >> 2, wc = wid & 3, fr = lane & 15, fq = lane >> 4;
    const int K = g.K, nt = K / BK;
    unsigned voffA[2], voffB[2];
#pragma unroll
    for (int i = 0; i < 2; ++i) { int R, C; stage_rc(tid * 16 + i * 8192, R, C); const int Rb = Epi::PERM ? ((R & ~31) + perm32(R & 31)) : R;
        voffA[i] = (unsigned)(R * K + C) * 2u; voffB[i] = (unsigned)(Rb * K + C) * 2u; }
    const size_t kstep = (size_t)(BK * 2);
    const size_t hstep = (size_t)HALF * K * 2;
    const size_t tstep = 2 * hstep;
    const unsigned ldsw = (unsigned)wid * 1024u;
    const int aoff = lds_byte(wr * 64 + fr, fq * 8), boff = lds_byte(wc * 32 + fr, fq * 8);
#define PG8_SA(b, h) (((b) * 2 + (h)) * HTB)
#define PG8_SB(b, h) ((4 + (b) * 2 + (h)) * HTB)
#define PG8_STAGE(bufoff, gbase, voff) do { _Pragma("unroll") for (int _i = 0; _i < 2; ++_i) \
        __builtin_amdgcn_global_load_lds((const unsigned*)((const char*)(gbase) + (voff)[_i]), (PG8_LAS unsigned*)(lds + (bufoff) + ldsw + _i * 8192), 16, 0, 0); } while (0)
#define PG8_LDA(dst, b, h) do { _Pragma("unroll") for (int m = 0; m < 4; ++m) _Pragma("unroll") for (int k = 0; k < 2; ++k) dst[m][k] = *(const PG8_LAS bf16x8*)(lds + PG8_SA(b, h) + aoff + m * 2048 + k * 1024); } while (0)
#define PG8_LDB(dst, b, h) do { _Pragma("unroll") for (int n = 0; n < 2; ++n) _Pragma("unroll") for (int k = 0; k < 2; ++k) dst[n][k] = *(const PG8_LAS bf16x8*)(lds + PG8_SB(b, h) + boff + n * 2048 + k * 1024); } while (0)
#define PG8_MMA(ai, bj, At, Bt) do { __builtin_amdgcn_s_setprio(1); _Pragma("unroll") for (int m = 0; m < 4; ++m) _Pragma("unroll") for (int n = 0; n < 2; ++n) _Pragma("unroll") for (int k = 0; k < 2; ++k) \
        acc[ai][bj][m][n] = __builtin_amdgcn_mfma_f32_16x16x32_bf16(Bt[n][k], At[m][k], acc[ai][bj][m][n], 0, 0, 0); __builtin_amdgcn_s_setprio(0); } while (0)
#define PG8_WAIT_V(n) asm volatile("s_waitcnt vmcnt(" #n ")" ::: "memory")
#define PG8_WAIT_L(n) asm volatile("s_waitcnt lgkmcnt(" #n ")" ::: "memory")
#define PG8_BAR __builtin_amdgcn_s_barrier()
#define PG8_SCHED __builtin_amdgcn_sched_barrier(0)
    Unit cur, nxt; int ui = 0;
    if (!S.next(0, cur)) return;
    f32x4 acc[2][2][4][2];
#pragma unroll
    for (int a = 0; a < 2; ++a)
#pragma unroll
        for (int b = 0; b < 2; ++b)
#pragma unroll
            for (int m = 0; m < 4; ++m)
#pragma unroll
                for (int n = 0; n < 2; ++n) acc[a][b][m][n] = (f32x4){0.f, 0.f, 0.f, 0.f};
    bf16x8 At[4][2], B0[2][2], B1[2][2];
    const char* cA = (const char*)g.A + (size_t)cur.pm * tstep; const char* cB = (const char*)g.Bt + (size_t)cur.pn * tstep;
    S.a_ready(cur);
    if constexpr (SP2) {
        PG8_STAGE(PG8_SB(0, 0), cB, voffB); PG8_STAGE(PG8_SB(0, 1), cB + hstep, voffB); PG8_STAGE(PG8_SA(0, 0), cA, voffA); PG8_STAGE(PG8_SA(0, 1), cA + hstep, voffA);
        if (wr == 1) PG8_BAR;
        PG8_WAIT_V(2); PG8_BAR;
        PG8_STAGE(PG8_SB(1, 0), cB + kstep, voffB); PG8_STAGE(PG8_SA(1, 0), cA + kstep, voffA); PG8_STAGE(PG8_SB(1, 1), cB + hstep + kstep, voffB);
        PG8_WAIT_V(6); PG8_BAR;
    } else {
        PG8_STAGE(PG8_SB(0, 0), cB, voffB); PG8_STAGE(PG8_SA(0, 0), cA, voffA); PG8_STAGE(PG8_SB(0, 1), cB + hstep, voffB); PG8_STAGE(PG8_SA(0, 1), cA + hstep, voffA);
        if (wr == 1) PG8_BAR;
        PG8_WAIT_V(4); PG8_BAR;
        PG8_STAGE(PG8_SB(1, 0), cB + kstep, voffB); PG8_STAGE(PG8_SA(1, 0), cA + kstep, voffA); PG8_STAGE(PG8_SB(1, 1), cB + hstep + kstep, voffB);
        PG8_WAIT_V(6); PG8_BAR;
    }
    for (;;) {
        const bool has_next = S.next(ui + 1, nxt);
        const char* nA = has_next ? (const char*)g.A + (size_t)nxt.pm * tstep : cA; const char* nB = has_next ? (const char*)g.Bt + (size_t)nxt.pn * tstep : cB;
        for (int t = 0; t < nt; t += 2) {
            const bool last = (t == nt - 2);
            const char* a1 = cA + (size_t)(t + 1) * kstep;
            const char* a2 = last ? nA : cA + (size_t)(t + 2) * kstep; const char* b2 = last ? nB : cB + (size_t)(t + 2) * kstep;
            const char* a3 = a2 + kstep; const char* b3 = b2 + kstep;
            if (last && has_next) S.a_ready(nxt);
            if constexpr (SP2) {
            PG8_LDB(B0, 0, 0); PG8_LDB(B1, 0, 1); PG8_SCHED; PG8_LDA(At, 0, 0); PG8_STAGE(PG8_SA(1, 1), a1 + hstep, voffA);
            PG8_WAIT_V(8); PG8_WAIT_L(0); PG8_BAR; PG8_MMA(0, 0, At, B0); PG8_MMA(0, 1, At, B1); PG8_BAR; PG8_SCHED;
            PG8_LDA(At, 0, 1); PG8_STAGE(PG8_SB(0, 0), b2, voffB); PG8_STAGE(PG8_SB(0, 1), b2 + hstep, voffB); PG8_STAGE(PG8_SA(0, 0), a2, voffA);
            PG8_WAIT_V(8); PG8_WAIT_L(0); PG8_BAR; PG8_MMA(1, 0, At, B0); PG8_MMA(1, 1, At, B1); PG8_BAR; PG8_SCHED;
            PG8_LDB(B0, 1, 0); PG8_LDB(B1, 1, 1); PG8_SCHED; PG8_LDA(At, 1, 0); PG8_STAGE(PG8_SA(0, 1), a2 + hstep, voffA);
            PG8_WAIT_V(8); PG8_WAIT_L(0); PG8_BAR; PG8_MMA(0, 0, At, B0); PG8_MMA(0, 1, At, B1); PG8_BAR; PG8_SCHED;
            PG8_LDA(At, 1, 1); PG8_STAGE(PG8_SB(1, 0), b3, voffB); PG8_STAGE(PG8_SB(1, 1), b3 + hstep, voffB); PG8_STAGE(PG8_SA(1, 0), a3, voffA);
            PG8_WAIT_V(8); PG8_WAIT_L(0); PG8_BAR; PG8_MMA(1, 0, At, B0); PG8_MMA(1, 1, At, B1); PG8_BAR; PG8_SCHED;
            } else {
            PG8_LDB(B0, 0, 0); PG8_SCHED; PG8_LDA(At, 0, 0); PG8_STAGE(PG8_SA(1, 1), a1 + hstep, voffA);
            PG8_WAIT_L(8); PG8_BAR; PG8_WAIT_L(0); PG8_MMA(0, 0, At, B0); PG8_BAR; PG8_SCHED;
            PG8_LDB(B1, 0, 1); PG8_STAGE(PG8_SB(0, 0), b2, voffB);
            PG8_BAR; PG8_WAIT_L(0); PG8_MMA(0, 1, At, B1); PG8_BAR;
            PG8_LDA(At, 0, 1); PG8_STAGE(PG8_SA(0, 0), a2, voffA);
            PG8_BAR; PG8_WAIT_L(0); PG8_MMA(1, 0, At, B0); PG8_BAR; PG8_SCHED;
            PG8_STAGE(PG8_SB(0, 1), b2 + hstep, voffB);
            PG8_WAIT_V(6); PG8_BAR; PG8_MMA(1, 1, At, B1); PG8_BAR;
            PG8_LDB(B0, 1, 0); PG8_SCHED; PG8_LDA(At, 1, 0); PG8_STAGE(PG8_SA(0, 1), a2 + hstep, voffA);
            PG8_WAIT_L(8); PG8_BAR; PG8_WAIT_L(0); PG8_MMA(0, 0, At, B0); PG8_BAR; PG8_SCHED;
            PG8_LDB(B1, 1, 1); PG8_STAGE(PG8_SB(1, 0), b3, voffB);
            PG8_BAR; PG8_WAIT_L(0); PG8_MMA(0, 1, At, B1); PG8_BAR;
            PG8_LDA(At, 1, 1); PG8_STAGE(PG8_SA(1, 0), a3, voffA);
            PG8_BAR; PG8_WAIT_L(0); PG8_MMA(1, 0, At, B0); PG8_BAR; PG8_SCHED;
            PG8_STAGE(PG8_SB(1, 1), b3 + hstep, voffB);
            PG8_WAIT_V(6); PG8_BAR; PG8_MMA(1, 1, At, B1); PG8_BAR;
            }
        }
        if constexpr (ALIGN_EPI) { if (wr == 0) PG8_BAR; }
        if constexpr (!Epi::AFTER_DRAIN) { E(acc, cur, wr, wc, fr, fq); S.done(cur); }
        if (!has_next) break;
#pragma unroll
        for (int a = 0; a < 2; ++a)
#pragma unroll
            for (int b = 0; b < 2; ++b)
#pragma unroll
                for (int m = 0; m < 4; ++m)
#pragma unroll
                    for (int n = 0; n < 2; ++n) acc[a][b][m][n] = (f32x4){0.f, 0.f, 0.f, 0.f};
        cur = nxt; cA = nA; cB = nB; ++ui;
        if constexpr (ALIGN_EPI) { if (wr == 1) PG8_BAR; }
    }
    PG8_WAIT_V(0);
    if constexpr (!ALIGN_EPI) { if (wr == 0) PG8_BAR; }
    PG8_BAR;
    if constexpr (Epi::AFTER_DRAIN) { E.fused(acc, cur, wr, wc, fr, fq, lds, wid, lane); S.done(cur); }
#undef PG8_SA
#undef PG8_SB
#undef PG8_STAGE
#undef PG8_LDA
#undef PG8_LDB
#undef PG8_MMA
#undef PG8_WAIT_V
#undef PG8_WAIT_L
#undef PG8_BAR
#undef PG8_SCHED
}
}

#define LAS __attribute__((address_space(3)))
typedef unsigned short bf16_t;
typedef short bf16x8 __attribute__((ext_vector_type(8)));
typedef short s16x4 __attribute__((ext_vector_type(4)));
typedef float f32x4 __attribute__((ext_vector_type(4)));
typedef float f32x16 __attribute__((ext_vector_type(16)));
typedef unsigned u32x4 __attribute__((ext_vector_type(4)));
typedef unsigned u32x2 __attribute__((ext_vector_type(2)));
constexpr int NWAVES = 8, NTHREADS = 512;
constexpr int LDS_BYTES = 139264;
__device__ __forceinline__ unsigned pk_bf16(float lo, float hi) { unsigned r; asm volatile("v_cvt_pk_bf16_f32 %0, %1, %2" : "=v"(r) : "v"(lo), "v"(hi)); return r; }
__device__ __forceinline__ float bf_lo(unsigned w) { return __uint_as_float(w << 16); }
__device__ __forceinline__ float bf_hi(unsigned w) { return __uint_as_float(w & 0xffff0000u); }

constexpr size_t WS_CTL = 0, CTL_BYTES = 4096;
constexpr size_t WS_TAB = 65536;
constexpr int TABA_W = 513, TABC_W = 385, TABA_N = 12 * TABA_W, TABC_N = 24 * TABC_W, ROPE_N = 64 * 16 * 2;
constexpr size_t WS_WIN = 1u << 20;
constexpr size_t WS_WOUT = WS_WIN + (size_t)2 * NP * DM * 2;
constexpr size_t WS_H = WS_WOUT + (size_t)2 * DM * DM * 2;
constexpr size_t WS_P = WS_H + (size_t)MT * DM * 2;
constexpr size_t WS_CS = WS_P + (size_t)MT * NP * 2;
constexpr size_t WS_LSE = WS_CS + (size_t)3 * MT * 512 * 2;
constexpr size_t WS_END = WS_LSE + (size_t)3 * MT * 8 * 4;

__constant__ float INVF[16] = {1.0f, 0.5623413251903491f, 0.31622776601683794f, 0.1778279410038923f, 0.1f, 0.05623413251903491f, 0.03162277660168379f, 0.01778279410038923f,
                               0.01f, 0.005623413251903491f, 0.0031622776601683794f, 0.0017782794100389228f, 0.001f, 0.0005623413251903491f, 0.00031622776601683794f, 0.00017782794100389227f};

struct Params {
    const float* x_prompt; const float* x_sample; const float* ln_g; const float* w_in; const float* qna; const float* kna; const float* sink; const float* qnb; const float* knb;
    const float* qnc; const float* knc; const float* rel_bias; const float* w_out; float* out; unsigned char* ws;
};

__device__ __forceinline__ int t5_bucket(int rel) {
    const int n = rel < 0 ? -rel : rel;
    const int large = 8 + (n >= 15) + (n >= 27) + (n >= 50) + (n >= 91) + (n >= 166) + (n >= 305) + (n >= 559);
    return (rel > 0 ? 16 : 0) + (n < 8 ? n : large);
}
template <bool PERMUTE>
__device__ __forceinline__ void transpose_item(const float* W, int K, int N, bf16_t* WT, LAS float* scr, int item, int lane) {
    const int nblk = N / 32, kb = item / nblk, nb = item % nblk, k0 = 64 * kb, n0 = 32 * nb;
    float wv[32];
#pragma unroll
    for (int i = 0; i < 32; ++i) wv[i] = W[(size_t)(k0 + 2 * i + (lane >> 5)) * N + n0 + (lane & 31)];
#pragma unroll
    for (int i = 0; i < 32; ++i) scr[(2 * i + (lane >> 5)) * 33 + (lane & 31)] = wv[i];
    asm volatile("s_waitcnt lgkmcnt(0)" ::: "memory");
    const int c = lane & 7;
    const int r0 = PERMUTE ? (256 * (n0 >> 8) + 128 * ((n0 >> 5) & 1) + 32 * ((n0 >> 6) & 3)) : n0;
#pragma unroll
    for (int j = 0; j < 4; ++j) { const int n = (lane >> 3) + 8 * j; const LAS float* s = scr + (8 * c) * 33 + n;
        u32x4 o; o.x = pk_bf16(s[0 * 33], s[1 * 33]); o.y = pk_bf16(s[2 * 33], s[3 * 33]); o.z = pk_bf16(s[4 * 33], s[5 * 33]); o.w = pk_bf16(s[6 * 33], s[7 * 33]);
        *(u32x4*)(WT + (size_t)(r0 + n) * K + k0 + 8 * c) = o; }
    asm volatile("s_waitcnt lgkmcnt(0)" ::: "memory");
}
__device__ __forceinline__ void prologue_phase(const Params& p, LAS unsigned char* lds, int tid, int wave, int lane) {
    LAS float* scr = (LAS float*)(lds + wave * 16384);
    const int gw = blockIdx.x * NWAVES + wave, NGW = gridDim.x * NWAVES;
    constexpr int I_IN = (DM / 64) * (NP / 32), I_OUT = (DM / 64) * (DM / 32);
    bf16_t* win = (bf16_t*)(p.ws + WS_WIN); bf16_t* wout = (bf16_t*)(p.ws + WS_WOUT);
    for (int it = gw; it < 2 * (I_IN + I_OUT); it += NGW) {
        int r = it;
        if (r < 2 * I_IN) { const int l = r / I_IN; r -= l * I_IN; transpose_item<true>(p.w_in + (size_t)l * DM * NP, DM, NP, win + (size_t)l * NP * DM, scr, r, lane); }
        else { r -= 2 * I_IN; const int l = r / I_OUT; r -= l * I_OUT; transpose_item<false>(p.w_out + (size_t)l * DM * DM, DM, DM, wout + (size_t)l * DM * DM, scr, r, lane); }
    }
    float* tab = (float*)(p.ws + WS_TAB);
    for (int i = blockIdx.x * NTHREADS + tid; i < TABA_N + TABC_N + ROPE_N / 2; i += gridDim.x * NTHREADS) {
        if (i < TABA_N) { const int h = i / TABA_W, rel = i % TABA_W - 256; tab[i] = (rel >= -128 && rel <= 128) ? p.rel_bias[t5_bucket(rel) * 36 + h] * LOG2E : -INFINITY; }
        else if (i < TABA_N + TABC_N) { const int j = i - TABA_N, gh = j / TABC_W, rel = j % TABC_W - 192, g = gh >> 3; const int dil = (g == 0) ? 1 : (g == 1 ? 4 : 16);
            tab[i] = (rel >= -64 && rel <= 64) ? p.rel_bias[t5_bucket(rel * dil) * 36 + 12 + gh] * LOG2E : -INFINITY; }
        else { const int j = i - TABA_N - TABC_N, pos = j >> 4, f = j & 15; const float ang = (float)pos * INVF[f];
            tab[TABA_N + TABC_N + 2 * j] = cosf(ang); tab[TABA_N + TABC_N + 2 * j + 1] = sinf(ang); }
    }
}
__device__ __forceinline__ void norm_phase(const float* x0, const float* x1, const float* g, bf16_t* H, int wave, int lane) {
    const int gw = blockIdx.x * NWAVES + wave, NGW = gridDim.x * NWAVES;
    f32x4 nx[8];
    { const f32x4* xr = (const f32x4*)((gw < MP) ? x0 + (size_t)gw * DM : x1 + (size_t)(gw - MP) * DM) + lane;
#pragma unroll
      for (int j = 0; j < 8; ++j) nx[j] = xr[64 * j]; }
    for (int row = gw; row < MT; row += NGW) {
        f32x4 v[8]; float s = 0.f;
#pragma unroll
        for (int j = 0; j < 8; ++j) v[j] = nx[j];
        const int nr = row + NGW;
        if (nr < MT) { const f32x4* xr = (const f32x4*)((nr < MP) ? x0 + (size_t)nr * DM : x1 + (size_t)(nr - MP) * DM) + lane;
#pragma unroll
            for (int j = 0; j < 8; ++j) nx[j] = xr[64 * j]; }
#pragma unroll
        for (int j = 0; j < 8; ++j) s += (v[j][0] * v[j][0] + v[j][1] * v[j][1]) + (v[j][2] * v[j][2] + v[j][3] * v[j][3]);
#pragma unroll
        for (int o = 1; o < 64; o <<= 1) s += __shfl_xor(s, o);
        const float rs = 1.0f / sqrtf(s * (1.0f / DM) + RMS_EPS);
        u32x2* o8 = (u32x2*)(H + (size_t)row * DM) + lane;
#pragma unroll
        for (int j = 0; j < 8; ++j) { const f32x4 gv = ((const f32x4*)g)[lane + 64 * j]; u32x2 o;
            o.x = pk_bf16(v[j][0] * rs * gv[0], v[j][1] * rs * gv[1]); o.y = pk_bf16(v[j][2] * rs * gv[2], v[j][3] * rs * gv[3]); o8[64 * j] = o; }
    }
}

namespace att {
constexpr int KP = 144, VP = 192, KBUF = 64 * KP, VBUF = 64 * VP, BUFB = KBUF + VBUF;
constexpr int L_TAB = 2 * BUFB, L_SLOT = L_TAB + (TABA_N + TABC_N) * 4;
static_assert(L_SLOT + 64 <= LDS_BYTES, "attention LDS map");
constexpr int N_BS = 768, N_BP = 192, N_A = 960, N_C = 1920, N_UNITS = N_BS + N_BP + N_A + N_C;
constexpr float THR = 5.0f;
typedef short v4i16_t __attribute__((ext_vector_type(4)));
__device__ __forceinline__ s16x4 vtr(const LAS unsigned char* p) { return __builtin_bit_cast(s16x4, __builtin_amdgcn_ds_read_tr16_b64_v4i16((LAS v4i16_t*)p)); }
#define MFMA32(a, b, c) __builtin_amdgcn_mfma_f32_32x32x16_bf16((a), (b), (c), 0, 0, 0)

struct UnitP { int rowbase, dil, rho, i0, t_lo, t_hi, qcol, kcol, vcol, gcol, ocol, tabidx, g, kvi; };

__device__ __forceinline__ void softmax_step(f32x16& p0, f32x16& p1, float& m, float& l, f32x16& o0, f32x16& o1) {
    float a = fmaxf(fmaxf(p0[0], p0[1]), p1[0]), b = fmaxf(fmaxf(p0[2], p0[3]), p1[1]); a = fmaxf(fmaxf(a, p1[2]), p1[3]);
#pragma unroll
    for (int r = 4; r < 16; r += 4) { a = fmaxf(fmaxf(a, p0[r]), p0[r + 1]); b = fmaxf(fmaxf(b, p0[r + 2]), p0[r + 3]); a = fmaxf(fmaxf(a, p1[r]), p1[r + 1]); b = fmaxf(fmaxf(b, p1[r + 2]), p1[r + 3]); }
    float rm = fmaxf(a, b);
    { auto rr = __builtin_amdgcn_permlane32_swap(__float_as_uint(rm), __float_as_uint(rm), false, false); rm = fmaxf(__uint_as_float(rr[0]), __uint_as_float(rr[1])); }
    if (__any(rm > m + THR)) { const float mn = fmaxf(m, rm), al = __builtin_amdgcn_exp2f(m - mn); m = mn; l *= al; o0 = o0 * al; o1 = o1 * al; }
    float ls0 = 0.f, ls1 = 0.f;
#pragma unroll
    for (int r = 0; r < 16; ++r) { p0[r] = __builtin_amdgcn_exp2f(p0[r] - m); p1[r] = __builtin_amdgcn_exp2f(p1[r] - m); ls0 += p0[r]; ls1 += p1[r]; }
    l += ls0 + ls1;
}
__device__ __forceinline__ bf16x8 pack8(const f32x16& x, int s) {
    u32x4 w; w.x = pk_bf16(x[8 * s], x[8 * s + 1]); w.y = pk_bf16(x[8 * s + 2], x[8 * s + 3]); w.z = pk_bf16(x[8 * s + 4], x[8 * s + 5]); w.w = pk_bf16(x[8 * s + 6], x[8 * s + 7]);
    return __builtin_bit_cast(bf16x8, w);
}
template <int MODE>
__device__ __forceinline__ void store_block(const Params& p, const UnitP& u, const f32x16& o0, const f32x16& o1, float m, float l, float m_sink, size_t qrow, int hq, int hi) {
    const bf16_t* __restrict__ P = (const bf16_t*)(p.ws + WS_P);
    float lt; { auto rr = __builtin_amdgcn_permlane32_swap(__float_as_uint(l), __float_as_uint(l), false, false); lt = __uint_as_float(rr[0]) + __uint_as_float(rr[1]); }
    if (MODE == 0) lt += __builtin_amdgcn_exp2f(m_sink - m);
    const float inv = __builtin_amdgcn_rcpf(lt);
    if (MODE != 2) {
        bf16_t* mix = (bf16_t*)(p.ws + WS_H) + qrow * DM + u.ocol + hq * 64 + 4 * hi;
        const bf16_t* gp = P + qrow * NP + u.gcol + hq * 64 + 4 * hi;
#pragma unroll
        for (int g = 0; g < 4; ++g) {
            const u32x2 g0 = *(const u32x2*)(gp + 8 * g), g1 = *(const u32x2*)(gp + 32 + 8 * g); u32x2 w0, w1;
            w0.x = pk_bf16(o0[4 * g] * inv * bf_lo(g0.x), o0[4 * g + 1] * inv * bf_hi(g0.x)); w0.y = pk_bf16(o0[4 * g + 2] * inv * bf_lo(g0.y), o0[4 * g + 3] * inv * bf_hi(g0.y));
            w1.x = pk_bf16(o1[4 * g] * inv * bf_lo(g1.x), o1[4 * g + 1] * inv * bf_hi(g1.x)); w1.y = pk_bf16(o1[4 * g + 2] * inv * bf_lo(g1.y), o1[4 * g + 3] * inv * bf_hi(g1.y));
            *(u32x2*)(mix + 8 * g) = w0; *(u32x2*)(mix + 32 + 8 * g) = w1;
        }
    } else {
        bf16_t* cs = (bf16_t*)(p.ws + WS_CS) + ((size_t)u.g * MT + qrow) * 512 + (u.kvi * 4 + hq) * 64 + 4 * hi;
#pragma unroll
        for (int g = 0; g < 4; ++g) { u32x2 w0, w1;
            w0.x = pk_bf16(o0[4 * g] * inv, o0[4 * g + 1] * inv); w0.y = pk_bf16(o0[4 * g + 2] * inv, o0[4 * g + 3] * inv);
            w1.x = pk_bf16(o1[4 * g] * inv, o1[4 * g + 1] * inv); w1.y = pk_bf16(o1[4 * g + 2] * inv, o1[4 * g + 3] * inv);
            *(u32x2*)(cs + 8 * g) = w0; *(u32x2*)(cs + 32 + 8 * g) = w1; }
        if (hi == 0) ((float*)(p.ws + WS_LSE))[((size_t)u.g * MT + qrow) * 8 + u.kvi * 4 + hq] = m + __builtin_amdgcn_logf(lt);
    }
}
template <int MODE, bool SEQ>
__device__ __forceinline__ void tile_loop(const UnitP& u, const bf16_t* kg, const bf16_t* vg, size_t tstep, u32x4 kreg, u32x4 vreg, LAS unsigned char* kst, LAS unsigned char* vst,
                                          const LAS unsigned char* krd, const LAS unsigned char* vrd, const LAS float* btab, int iqa, int hi, int wt_lo, int wt_hi,
                                          const bf16x8 (&qa)[4], const bf16x8 (&qb)[4], float& ma, float& la, float& mb, float& lb, f32x16& oa0, f32x16& oa1, f32x16& ob0, f32x16& ob1) {
    for (int t = u.t_lo; t <= u.t_hi; ++t) {
        const int boff = ((t - u.t_lo) & 1) * BUFB;
        __syncthreads();
        if (t < u.t_hi) { kreg = *(const u32x4*)(kg + (size_t)(t + 1) * tstep); vreg = *(const u32x4*)(vg + (size_t)(t + 1) * tstep); }
        if (MODE == 1 || (t >= wt_lo && t <= wt_hi)) {
          const LAS float* bt = btab + (64 * t - iqa + 4 * hi);
          if (!SEQ) {
            f32x16 pa0 = {}, pa1 = {}, pb0 = {}, pb1 = {};
#pragma unroll
            for (int ds = 0; ds < 4; ++ds) {
                const bf16x8 k0 = *(const LAS bf16x8*)(krd + boff + ds * 32), k1 = *(const LAS bf16x8*)(krd + boff + 32 * KP + ds * 32);
                pa0 = MFMA32(k0, qa[ds], pa0); pa1 = MFMA32(k1, qa[ds], pa1); pb0 = MFMA32(k0, qb[ds], pb0); pb1 = MFMA32(k1, qb[ds], pb1);
            }
            __builtin_amdgcn_sched_barrier(0);
            if (MODE != 1) {
#pragma unroll
                for (int r = 0; r < 16; ++r) { const int o = (r & 3) + 8 * (r >> 2);
                    pa0[r] += bt[o]; pa1[r] += bt[o + 32]; pb0[r] += bt[o - 32]; pb1[r] += bt[o]; }
            }
            softmax_step(pa0, pa1, ma, la, oa0, oa1);
            softmax_step(pb0, pb1, mb, lb, ob0, ob1);
            __builtin_amdgcn_sched_barrier(0);
#pragma unroll
            for (int s = 0; s < 4; ++s) {
                const bf16x8 xa = (s < 2) ? pack8(pa0, s & 1) : pack8(pa1, s & 1), xb = (s < 2) ? pack8(pb0, s & 1) : pack8(pb1, s & 1);
                const LAS unsigned char* vb = vrd + boff + s * 16 * VP;
                const s16x4 a0 = vtr(vb), a1 = vtr(vb + 8 * VP), b0 = vtr(vb + 64), b1 = vtr(vb + 8 * VP + 64);
                const bf16x8 vf0 = __builtin_shufflevector(a0, a1, 0, 1, 2, 3, 4, 5, 6, 7), vf1 = __builtin_shufflevector(b0, b1, 0, 1, 2, 3, 4, 5, 6, 7);
                oa0 = MFMA32(vf0, xa, oa0); oa1 = MFMA32(vf1, xa, oa1); ob0 = MFMA32(vf0, xb, ob0); ob1 = MFMA32(vf1, xb, ob1);
                __builtin_amdgcn_sched_barrier(0);
            }
          } else {
#define ATT_ONE_BLOCK(QF, M_, L_, O0, O1, BOFS) do { \
            f32x16 p0 = {}, p1 = {}; \
            _Pragma("unroll") for (int ds = 0; ds < 4; ++ds) { \
                const bf16x8 k0 = *(const LAS bf16x8*)(krd + boff + ds * 32), k1 = *(const LAS bf16x8*)(krd + boff + 32 * KP + ds * 32); \
                p0 = MFMA32(k0, QF[ds], p0); p1 = MFMA32(k1, QF[ds], p1); } \
            __builtin_amdgcn_sched_barrier(0); \
            if (MODE != 1) { _Pragma("unroll") for (int r = 0; r < 16; ++r) { const int o = (r & 3) + 8 * (r >> 2); p0[r] += bt[o + (BOFS)]; p1[r] += bt[o + 32 + (BOFS)]; } } \
            softmax_step(p0, p1, M_, L_, O0, O1); \
            __builtin_amdgcn_sched_barrier(0); \
            _Pragma("unroll") for (int s = 0; s < 4; ++s) { \
                const bf16x8 xs = (s < 2) ? pack8(p0, s & 1) : pack8(p1, s & 1); \
                const LAS unsigned char* vb = vrd + boff + s * 16 * VP; \
                const s16x4 a0 = vtr(vb), a1 = vtr(vb + 8 * VP), b0 = vtr(vb + 64), b1 = vtr(vb + 8 * VP + 64); \
                const bf16x8 vf0 = __builtin_shufflevector(a0, a1, 0, 1, 2, 3, 4, 5, 6, 7), vf1 = __builtin_shufflevector(b0, b1, 0, 1, 2, 3, 4, 5, 6, 7); \
                O0 = MFMA32(vf0, xs, O0); O1 = MFMA32(vf1, xs, O1); } \
            __builtin_amdgcn_sched_barrier(0); } while (0)
            ATT_ONE_BLOCK(qa, ma, la, oa0, oa1, 0);
            ATT_ONE_BLOCK(qb, mb, lb, ob0, ob1, -32);
#undef ATT_ONE_BLOCK
          }
        }
        if (t < u.t_hi) { *(LAS u32x4*)(kst + (BUFB - boff)) = kreg; *(LAS u32x4*)(vst + (BUFB - boff)) = vreg; }
    }
}
template <int MODE>
__device__ __forceinline__ void unit(LAS unsigned char* lds, const Params& p, const UnitP& u, int tid, int wave, int lane) {
    const bf16_t* __restrict__ P = (const bf16_t*)(p.ws + WS_P);
    const int r32 = lane & 31, hi = lane >> 5, hq = wave >> 1, sub = wave & 1;
    const int iqa = u.i0 + 64 * sub + r32;
    const size_t qrow_a = (size_t)(u.rowbase + u.rho + u.dil * iqa), qrow_b = qrow_a + (size_t)(32 * u.dil);
    constexpr int W = (MODE == 0) ? 128 : 64, TW = (MODE == 0) ? TABA_W : TABC_W, TC = (MODE == 0) ? 256 : 192;
    const int kk = tid >> 3, ch = tid & 7;
    const bf16_t* kg = P + (size_t)(u.rowbase + u.rho + u.dil * kk) * NP + u.kcol + ch * 8;
    const bf16_t* vg = P + (size_t)(u.rowbase + u.rho + u.dil * kk) * NP + u.vcol + ch * 8;
    const size_t tstep = (size_t)64 * u.dil * NP;
    u32x4 kreg = *(const u32x4*)(kg + (size_t)u.t_lo * tstep), vreg = *(const u32x4*)(vg + (size_t)u.t_lo * tstep);
    bf16x8 qa[4], qb[4];
#pragma unroll
    for (int ds = 0; ds < 4; ++ds) { qa[ds] = *(const bf16x8*)(P + qrow_a * NP + u.qcol + hq * 64 + ds * 16 + hi * 8); qb[ds] = *(const bf16x8*)(P + qrow_b * NP + u.qcol + hq * 64 + ds * 16 + hi * 8); }
    LAS unsigned char* kst = lds + kk * KP + ch * 16; LAS unsigned char* vst = lds + KBUF + kk * VP + ch * 16;
    *(LAS u32x4*)kst = kreg; *(LAS u32x4*)vst = vreg;
    asm volatile("" :: "v"(qa[0]), "v"(qa[1]), "v"(qa[2]), "v"(qa[3]), "v"(qb[0]), "v"(qb[1]), "v"(qb[2]), "v"(qb[3]));
    const LAS unsigned char* krd = lds + r32 * KP + hi * 16;
    const LAS unsigned char* vrd = lds + KBUF + (4 * hi + ((lane & 15) >> 2)) * VP + ((lane >> 4) & 1) * 32 + (lane & 3) * 8;
    const LAS float* btab = (const LAS float*)(lds + L_TAB) + u.tabidx + hq * TW + TC;
    float m_sink = -1e30f;
    if (MODE == 0) m_sink = p.sink[u.g * 12 + u.kvi * 4 + hq] * LOG2E;
    float ma = m_sink, mb = m_sink, la = 0.f, lb = 0.f;
    f32x16 oa0 = {}, oa1 = {}, ob0 = {}, ob1 = {};
    int wt_lo = u.t_lo, wt_hi = u.t_hi;
    if (MODE != 1) { const int c = (u.i0 >> 6) + sub; wt_lo = c - W / 64 > wt_lo ? c - W / 64 : wt_lo; wt_hi = c + W / 64 < wt_hi ? c + W / 64 : wt_hi; }
    if (true) tile_loop<MODE, false>(u, kg, vg, tstep, kreg, vreg, kst, vst, krd, vrd, btab, iqa, hi, wt_lo, wt_hi, qa, qb, ma, la, mb, lb, oa0, oa1, ob0, ob1);
    else tile_loop<MODE, true>(u, kg, vg, tstep, kreg, vreg, kst, vst, krd, vrd, btab, iqa, hi, wt_lo, wt_hi, qa, qb, ma, la, mb, lb, oa0, oa1, ob0, ob1);
    store_block<MODE>(p, u, oa0, oa1, ma, la, m_sink, qrow_a, hq, hi);
    store_block<MODE>(p, u, ob0, ob1, mb, lb, m_sink, qrow_b, hq, hi);
}

__device__ __forceinline__ void seqblk_decode(int sb, int& rowbase, int& S, int& blk) {
    if (sb < 256) { rowbase = MP + (sb >> 5) * 4096; S = 4096; blk = sb & 31; } else { sb -= 256; rowbase = (sb >> 4) * 2048; S = 2048; blk = sb & 15; }
}
__device__ __forceinline__ void phase(LAS unsigned char* lds, const Params& p, int layer, int cslot, int ubeg, int uend, int tid, int wave, int lane) {
    { const float* gt = (const float*)(p.ws + WS_TAB); LAS float* lt = (LAS float*)(lds + L_TAB);
      for (int i = tid; i < TABA_N + TABC_N; i += NTHREADS) lt[i] = gt[i]; }
    unsigned* ctr = (unsigned*)(p.ws + WS_CTL) + 64 * cslot;
    volatile LAS int* slot = (volatile LAS int*)(lds + L_SLOT);
    int nxt = 0;
    if (tid == 0) { nxt = ubeg + (int)atomicAdd(ctr, 1u); *slot = nxt; }
    __syncthreads();
    int un = *slot;
    while (un < uend) {
        if (tid == 0) nxt = ubeg + (int)atomicAdd(ctr, 1u);
        UnitP u; u.dil = 1; u.rho = 0; u.g = 0; u.kvi = 0; u.tabidx = 0; u.gcol = 0; u.ocol = 0;
        if (un < N_BS + N_BP) {
            int b, kvh, blk, S;
            if (un < N_BS) { b = un / 96; const int rem = un % 96; kvh = rem >> 5; blk = rem & 31; u.rowbase = MP + b * 4096; S = 4096; }
            else { const int v = un - N_BS; b = v / 48; const int rem = v % 48; kvh = rem >> 4; blk = rem & 15; u.rowbase = b * 2048; S = 2048; }
            u.i0 = blk * 128; u.t_lo = 0; u.t_hi = S / 64 - 1; u.qcol = C_QB + kvh * 256; u.kcol = C_KB + kvh * 64; u.vcol = C_VB + kvh * 64; u.gcol = C_GB + kvh * 256; u.ocol = 768 + kvh * 256;
            unit<1>(lds, p, u, tid, wave, lane);
        } else if (un < N_BS + N_BP + N_A) {
            const int v = un - (N_BS + N_BP), sb = v / 3, kvh = v % 3; int S, blk; seqblk_decode(sb, u.rowbase, S, blk);
            u.i0 = blk * 128; u.t_lo = 2 * blk - 2 < 0 ? 0 : 2 * blk - 2; u.t_hi = 2 * blk + 3 > S / 64 - 1 ? S / 64 - 1 : 2 * blk + 3;
            u.qcol = C_QA + kvh * 256; u.kcol = C_KA + kvh * 64; u.vcol = C_VA + kvh * 64; u.gcol = C_GA + kvh * 256; u.ocol = kvh * 256; u.tabidx = kvh * 4 * TABA_W; u.g = layer; u.kvi = kvh;
            unit<0>(lds, p, u, tid, wave, lane);
        } else {
            const int v = un - (N_BS + N_BP + N_A), g = v / 640, r = v % 640, sb = r >> 1, kvi = r & 1; int S, blk; seqblk_decode(sb, u.rowbase, S, blk);
            const int dsh = 2 * g, nb = (S >> dsh) >> 7;
            u.dil = 1 << dsh; u.rho = blk / nb; const int lb = blk % nb; u.i0 = lb * 128; u.t_lo = 2 * lb - 1 < 0 ? 0 : 2 * lb - 1; u.t_hi = 2 * lb + 2 > 2 * nb - 1 ? 2 * nb - 1 : 2 * lb + 2;
            u.qcol = C_QC + (g * 8 + kvi * 4) * 64; u.kcol = C_KC + (g * 2 + kvi) * 64; u.vcol = C_VC + (g * 2 + kvi) * 64; u.tabidx = TABA_N + (g * 8 + kvi * 4) * TABC_W; u.g = g; u.kvi = kvi;
            unit<2>(lds, p, u, tid, wave, lane);
        }
        __syncthreads();
        if (tid == 0) *slot = nxt;
        __syncthreads();
        un = *slot;
    }
}
__device__ __forceinline__ void combine_one(const bf16_t* cs, const float* lse, const bf16_t* P, bf16_t* mix, size_t i) {
    const size_t row = i >> 6; const int hc = (int)(i >> 3) & 7, chk = (int)i & 7;
    const float l0 = lse[row * 8 + hc], l1 = lse[((size_t)MT + row) * 8 + hc], l2 = lse[((size_t)2 * MT + row) * 8 + hc];
    const u32x4 a = *(const u32x4*)(cs + row * 512 + hc * 64 + chk * 8), b = *(const u32x4*)(cs + ((size_t)MT + row) * 512 + hc * 64 + chk * 8),
                c = *(const u32x4*)(cs + ((size_t)2 * MT + row) * 512 + hc * 64 + chk * 8), gt = *(const u32x4*)(P + row * NP + C_GC + hc * 64 + chk * 8);
    const float mx = fmaxf(l0, fmaxf(l1, l2));
    float w0 = __builtin_amdgcn_exp2f(l0 - mx), w1 = __builtin_amdgcn_exp2f(l1 - mx), w2 = __builtin_amdgcn_exp2f(l2 - mx);
    const float inv = 1.0f / (w0 + w1 + w2); w0 *= inv; w1 *= inv; w2 *= inv;
    u32x4 o;
#pragma unroll
    for (int k = 0; k < 4; ++k) {
        const float lo = (w0 * bf_lo(a[k]) + w1 * bf_lo(b[k]) + w2 * bf_lo(c[k])) * bf_lo(gt[k]), hi = (w0 * bf_hi(a[k]) + w1 * bf_hi(b[k]) + w2 * bf_hi(c[k])) * bf_hi(gt[k]);
        o[k] = pk_bf16(lo, hi);
    }
    *(u32x4*)(mix + row * DM + 1536 + hc * 64 + chk * 8) = o;
}
__device__ __forceinline__ void combine_phase(const Params& p, int tid) {
    const bf16_t* cs = (const bf16_t*)(p.ws + WS_CS); const float* lse = (const float*)(p.ws + WS_LSE);
    const bf16_t* P = (const bf16_t*)(p.ws + WS_P); bf16_t* mix = (bf16_t*)(p.ws + WS_H);
    const size_t stride = (size_t)gridDim.x * NTHREADS, total = (size_t)MT * 64;
    size_t i = (size_t)blockIdx.x * NTHREADS + tid;
    for (; i + 3 * stride < total; i += 4 * stride) { combine_one(cs, lse, P, mix, i); combine_one(cs, lse, P, mix, i + stride); combine_one(cs, lse, P, mix, i + 2 * stride); combine_one(cs, lse, P, mix, i + 3 * stride); }
    for (; i < total; i += stride) combine_one(cs, lse, P, mix, i);
}
}

typedef const __attribute__((address_space(4))) Params* KParamsPtr;
__device__ __forceinline__ Params fresh_params() {
#if defined(__HIP_DEVICE_COMPILE__)
    KParamsPtr pp = (KParamsPtr)__builtin_amdgcn_kernarg_segment_ptr(); asm volatile("" : "+s"(pp)); Params r;
    r.x_prompt = pp->x_prompt; r.x_sample = pp->x_sample; r.ln_g = pp->ln_g; r.w_in = pp->w_in; r.qna = pp->qna; r.kna = pp->kna; r.sink = pp->sink; r.qnb = pp->qnb; r.knb = pp->knb;
    r.qnc = pp->qnc; r.knc = pp->knc; r.rel_bias = pp->rel_bias; r.w_out = pp->w_out; r.out = pp->out; r.ws = pp->ws; return r;
#else
    return Params{};
#endif
}
#define PHASE_IDS() int tid_l = threadIdx.x; asm volatile("" : "+v"(tid_l)); const int tid = tid_l, lane = tid & 63, wave = __builtin_amdgcn_readfirstlane(tid >> 6); (void)lane; (void)wave
__global__ void __launch_bounds__(NTHREADS, 2) fwd_megakernel(Params p_unused) {
    extern __shared__ __attribute__((aligned(16))) unsigned char lds_raw[];
    LAS unsigned char* lds = (LAS unsigned char*)lds_raw;
#ifndef NO_PRO
    { const Params p = fresh_params(); PHASE_IDS(); prologue_phase(p, lds, tid, wave, lane); }
#endif
    for (int layer = 0; layer < 2; ++layer) {
        asm volatile("" : "+s"(layer));
#ifndef NO_NORM
        { const Params p = fresh_params(); PHASE_IDS();
          const float* x0 = layer == 0 ? p.x_prompt : p.out; const float* x1 = layer == 0 ? p.x_sample : p.out + (size_t)MP * DM;
          norm_phase(x0, x1, p.ln_g + layer * DM, (bf16_t*)(p.ws + WS_H), wave, lane); }
#endif
        cg::this_grid().sync();
#if defined(NAIVE_G1)
        { const Params p = fresh_params(); PHASE_IDS(); naive_g1(p, layer, wave, lane); }
#endif
#if defined(NAIVE_G2X)
#endif
#ifndef NO_G1
        { const Params p = fresh_params();
          pg8::Gemm g{(const bf16_t*)(p.ws + WS_H), (const bf16_t*)(p.ws + WS_WIN) + (size_t)layer * NP * DM, MT, NP, DM}; pg8::StaticOrder S; S.init(MT, NP, (int)gridDim.x, (int)blockIdx.x);
          pg8::EpiProj E{(bf16_t*)(p.ws + WS_P), p.qna + layer * 64, p.kna + layer * 64, p.qnb + layer * 64, p.knb + layer * 64, p.qnc + layer * 64, p.knc + layer * 64, (const float*)(p.ws + WS_TAB) + TABA_N + TABC_N};
          pg8::gemm_phase<pg8::EpiProj, pg8::StaticOrder, true, true>(lds, g, S, E);
#if defined(REP_G1)
          pg8::gemm_phase<pg8::EpiProj, pg8::StaticOrder, true, true>(lds, g, S, E);
#endif
        }
#endif
        cg::this_grid().sync();
#ifndef NO_ATT
        { const Params p = fresh_params(); PHASE_IDS(); att::phase(lds, p, layer, layer, 0, att::N_UNITS, tid, wave, lane); }
#if defined(REP_ATT)
        cg::this_grid().sync();
        { const Params p = fresh_params(); PHASE_IDS(); att::phase(lds, p, layer, layer + 2, REP_ATT_LO, REP_ATT_HI, tid, wave, lane); }
#endif
#endif
        cg::this_grid().sync();
#ifndef NO_CMB
        { const Params p = fresh_params(); PHASE_IDS(); att::combine_phase(p, tid); }
#endif
        cg::this_grid().sync();
#if defined(NAIVE_MASK)
        { const Params p = fresh_params(); PHASE_IDS(); naive_attention(p, layer, wave, lane); }
        cg::this_grid().sync();
#endif
#if defined(NAIVE_G2)
        { const Params p = fresh_params(); PHASE_IDS(); naive_g2(p, layer, wave, lane); }
#endif
#ifndef NO_G2
        { const Params p = fresh_params();
          const float* x0 = layer == 0 ? p.x_prompt : p.out; const float* x1 = layer == 0 ? p.x_sample : p.out + (size_t)MP * DM;
          pg8::Gemm g{(const bf16_t*)(p.ws + WS_H), (const bf16_t*)(p.ws + WS_WOUT) + (size_t)layer * DM * DM, MT, DM, DM}; pg8::StaticOrder S; S.init(MT, DM, (int)gridDim.x, (int)blockIdx.x);
          pg8::EpiRes E{x0, x1, p.out};
          pg8::gemm_phase<pg8::EpiRes, pg8::StaticOrder, true, true>(lds, g, S, E); }
#endif
        if (layer == 0) cg::this_grid().sync();
    }
}

extern "C" void kernel_launch(void* const* d_in, const int* in_sizes, int n_in, void* d_out, int out_size, void* d_ws, size_t ws_size, hipStream_t stream) {
    static int grid_blocks = 0;
    if (grid_blocks == 0) {
        if (n_in != 13 || out_size != MT * DM || ws_size < WS_END) { fprintf(stderr, "kernel_launch: unexpected shapes (n_in %d, out %d, ws %zu < %zu)\n", n_in, out_size, ws_size, (size_t)WS_END); grid_blocks = -1; return; }
        int dev = 0, cus = 0, per_cu = 0;
        hipGetDevice(&dev); hipDeviceGetAttribute(&cus, hipDeviceAttributeMultiprocessorCount, dev);
        hipFuncSetAttribute((const void*)fwd_megakernel, hipFuncAttributeMaxDynamicSharedMemorySize, LDS_BYTES);
        hipOccupancyMaxActiveBlocksPerMultiprocessor(&per_cu, (const void*)fwd_megakernel, NTHREADS, LDS_BYTES);
        if (per_cu < 1) { fprintf(stderr, "kernel_launch: occupancy query says %d blocks/CU\n", per_cu); per_cu = 1; }
        (void)hipGetLastError();
        grid_blocks = cus * 1;
    }
    if (grid_blocks < 0) return;
    hipMemsetAsync((char*)d_ws + WS_CTL, 0, CTL_BYTES, stream);
    Params p{};
    p.x_prompt = (const float*)d_in[0]; p.x_sample = (const float*)d_in[1]; p.ln_g = (const float*)d_in[2]; p.w_in = (const float*)d_in[3]; p.qna = (const float*)d_in[4]; p.kna = (const float*)d_in[5];
    p.sink = (const float*)d_in[6]; p.qnb = (const float*)d_in[7]; p.knb = (const float*)d_in[8]; p.qnc = (const float*)d_in[9]; p.knc = (const float*)d_in[10]; p.rel_bias = (const float*)d_in[11];
    p.w_out = (const float*)d_in[12]; p.out = (float*)d_out; p.ws = (unsigned char*)d_ws;
    void* args[] = {&p};
    hipError_t e = hipLaunchCooperativeKernel((const void*)fwd_megakernel, dim3(grid_blocks), dim3(NTHREADS), args, LDS_BYTES, stream);
    if (e != hipSuccess) fprintf(stderr, "cooperative launch failed: %s (grid %d)\n", hipGetErrorString(e), grid_blocks);
}
```

```cpp
#include <hip/hip_runtime.h>
#include <hip/hip_cooperative_groups.h>
#include <cstdio>
#include <cstdint>
namespace cg = cooperative_groups;

constexpr int DM = 2048, NP = 6656, MP = 8192, MS = 32768, MT = MP + MS;
constexpr int C_QA = 0, C_KA = 768, C_VA = 960, C_GA = 1152, C_QB = 1920, C_KB = 2688, C_VB = 2880, C_GB = 3072, C_QC = 3840, C_KC = 5376, C_VC = 5760, C_GC = 6144;
constexpr float QSCALE = 0.125f * 1.4426950408889634f;
constexpr float LOG2E = 1.4426950408889634f;
constexpr float RMS_EPS = 1e-6f;

namespace pg8 {
#define PG8_LAS __attribute__((address_space(3)))
typedef unsigned short bf16_t;
typedef short bf16x8 __attribute__((ext_vector_type(8)));
typedef float f32x4 __attribute__((ext_vector_type(4)));
typedef unsigned u32x4 __attribute__((ext_vector_type(4)));
constexpr int BM = 256, BK = 64, HALF = 128, HTB = HALF * BK * 2  , STAGE_BYTES = 8 * HTB, NXCD = 8, WGM = 8;

__host__ __device__ __forceinline__ int lds_byte(int r, int c) { const int st = (r >> 4) * 2 + (c >> 5), rr = r & 15, cc = c & 31, ob = rr * 64 + cc * 2; return st * 1024 + (ob ^ (((ob >> 9) & 1) << 5)); }
__host__ __device__ __forceinline__ void stage_rc(int b, int& R, int& C) { const int st = b / 1024, sb = b % 1024, swz = sb ^ (((sb >> 9) & 1) << 5); R = (st >> 1) * 16 + swz / 64; C = (st & 1) * 32 + (swz % 64) / 2; }
__host__ __device__ __forceinline__ int perm32(int rho) { const int n = rho >> 4, i = rho & 15; return 8 * (i >> 2) + 4 * n + (i & 3); }

struct Unit { int pm, pn; };
struct Gemm { const bf16_t* A; const bf16_t* Bt; int M, N, K; };

struct StaticOrder {
    int nM, nN, nwg, G, c;
    __host__ __device__ void init(int M, int N, int G_, int c_) { nM = M / BM; nN = N / BM; nwg = nM * nN; G = G_; c = c_; }
    __host__ __device__ bool next(int i, Unit& u) const {
        const long L = (long)i * G + c; if (L >= nwg) return false;
        int wgid = (int)L; { const int q = nwg / NXCD, r = nwg % NXCD, xcd = wgid % NXCD, off = wgid / NXCD; wgid = (xcd < r ? xcd * (q + 1) : r * (q + 1) + (xcd - r) * q) + off; }
        const int nig = WGM * nN, gid = wgid / nig, fm = gid * WGM, gsz = (nM - fm) < WGM ? (nM - fm) : WGM;
        u.pm = fm + ((wgid % nig) % gsz); u.pn = (wgid % nig) / gsz; return true;
    }
    __device__ __forceinline__ void a_ready(const Unit&) const {}
    __device__ __forceinline__ void done(const Unit&) const {}
};

__device__ __forceinline__ unsigned cvt_pk_bf16(float lo, float hi) { unsigned r; asm volatile("v_cvt_pk_bf16_f32 %0, %1, %2" : "=v"(r) : "v"(lo), "v"(hi)); return r; }
typedef float f32x2e __attribute__((ext_vector_type(2)));
struct EpiProj {
    static constexpr bool PERM = true, AFTER_DRAIN = false;
    bf16_t* P; const float *qna, *kna, *qnb, *knb, *qnc, *knc; const float* rope;
    __device__ __forceinline__ void operator()(const f32x4 (&acc)[2][2][4][2], const Unit& u, int wr, int wc, int fr, int fq) const {
        const int hd = u.pn * 4 + wc;
        int type; const float* w = qna; float qs = 1.f;
        if (hd < 12) { type = 2; w = qna; qs = QSCALE; } else if (hd < 15) { type = 2; w = kna; } else if (hd < 18) { type = 0; } else if (hd < 30) { type = 1; }
        else if (hd < 42) { type = 3; w = qnb; qs = QSCALE; } else if (hd < 45) { type = 3; w = knb; } else if (hd < 48) { type = 0; } else if (hd < 60) { type = 1; }
        else if (hd < 84) { type = 2; w = qnc; qs = QSCALE; } else if (hd < 90) { type = 2; w = knc; } else if (hd < 96) { type = 0; } else { type = 1; }
        const int row0 = u.pm * BM + wr * 64 + fr;
        bf16_t* base = P + (size_t)row0 * NP + hd * 64 + 8 * fq;
        if (type == 0) {
#pragma unroll
            for (int ai = 0; ai < 2; ++ai)
#pragma unroll
                for (int m = 0; m < 4; ++m) { bf16_t* rowp = base + (size_t)(ai * HALF + m * 16) * NP;
#pragma unroll
                    for (int bj = 0; bj < 2; ++bj) { const f32x4 v0 = acc[ai][bj][m][0], v1 = acc[ai][bj][m][1]; u32x4 o;
                        o.x = cvt_pk_bf16(v0[0], v0[1]); o.y = cvt_pk_bf16(v0[2], v0[3]); o.z = cvt_pk_bf16(v1[0], v1[1]); o.w = cvt_pk_bf16(v1[2], v1[3]);
                        *(u32x4*)(rowp + bj * 32) = o; } }
        } else if (type == 1) {
#pragma unroll
            for (int ai = 0; ai < 2; ++ai)
#pragma unroll
                for (int m = 0; m < 4; ++m) { bf16_t* rowp = base + (size_t)(ai * HALF + m * 16) * NP;
#pragma unroll
                    for (int bj = 0; bj < 2; ++bj) { f32x4 v[2] = {acc[ai][bj][m][0], acc[ai][bj][m][1]};
#pragma unroll
                        for (int n = 0; n < 2; ++n)
#pragma unroll
                            for (int e = 0; e < 4; ++e) { const float g = v[n][e]; v[n][e] = g * __builtin_amdgcn_rcpf(1.f + __builtin_amdgcn_exp2f(-g * LOG2E)); }
                        u32x4 o; o.x = cvt_pk_bf16(v[0][0], v[0][1]); o.y = cvt_pk_bf16(v[0][2], v[0][3]); o.z = cvt_pk_bf16(v[1][0], v[1][1]); o.w = cvt_pk_bf16(v[1][2], v[1][3]);
                        *(u32x4*)(rowp + bj * 32) = o; } }
        } else {
            f32x4 wv[2][2];
#pragma unroll
            for (int bj = 0; bj < 2; ++bj)
#pragma unroll
                for (int n = 0; n < 2; ++n) wv[bj][n] = *(const f32x4*)(w + 32 * bj + 8 * fq + 4 * n);
            const float sgn = (fq < 2) ? -1.f : 1.f;
#pragma unroll
            for (int ai = 0; ai < 2; ++ai)
#pragma unroll
                for (int m = 0; m < 4; ++m) { bf16_t* rowp = base + (size_t)(ai * HALF + m * 16) * NP;
                    f32x4 v[2][2]; float ss = 0.f;
#pragma unroll
                    for (int bj = 0; bj < 2; ++bj)
#pragma unroll
                        for (int n = 0; n < 2; ++n) { v[bj][n] = acc[ai][bj][m][n]; const f32x4 x = v[bj][n]; ss += (x[0] * x[0] + x[1] * x[1]) + (x[2] * x[2] + x[3] * x[3]); }
                    ss += __shfl_xor(ss, 16); ss += __shfl_xor(ss, 32);
                    const float rs = __builtin_amdgcn_rsqf(ss * (1.0f / 64.0f) + RMS_EPS);
#pragma unroll
                    for (int bj = 0; bj < 2; ++bj)
#pragma unroll
                        for (int n = 0; n < 2; ++n) v[bj][n] = v[bj][n] * rs * wv[bj][n];
                    if (type == 3) {
                        const int r = row0 + ai * HALF + m * 16, t = r & ((r < MP) ? 2047 : 4095);
#pragma unroll
                        for (int bj = 0; bj < 2; ++bj) { const int pos = bj ? (t & 63) : (t >> 6);
#pragma unroll
                            for (int n = 0; n < 2; ++n) { const float* tp = rope + (size_t)(pos * 16 + 8 * (fq & 1) + 4 * n) * 2;
                                const f32x4 cs0 = *(const f32x4*)tp, cs1 = *(const f32x4*)(tp + 4); const f32x4 x = v[bj][n]; f32x4 pr;
                                pr[0] = __shfl_xor(x[0], 32); pr[1] = __shfl_xor(x[1], 32); pr[2] = __shfl_xor(x[2], 32); pr[3] = __shfl_xor(x[3], 32);
                                f32x4 y; y[0] = x[0] * cs0[0] + sgn * pr[0] * cs0[1]; y[1] = x[1] * cs0[2] + sgn * pr[1] * cs0[3];
                                y[2] = x[2] * cs1[0] + sgn * pr[2] * cs1[1]; y[3] = x[3] * cs1[2] + sgn * pr[3] * cs1[3]; v[bj][n] = y; } }
                    }
#pragma unroll
                    for (int bj = 0; bj < 2; ++bj) { const f32x4 v0 = v[bj][0] * qs, v1 = v[bj][1] * qs; u32x4 o;
                        o.x = cvt_pk_bf16(v0[0], v0[1]); o.y = cvt_pk_bf16(v0[2], v0[3]); o.z = cvt_pk_bf16(v1[0], v1[1]); o.w = cvt_pk_bf16(v1[2], v1[3]);
                        *(u32x4*)(rowp + bj * 32) = o; } }
        }
    }
};
struct EpiRes {
    static constexpr bool PERM = true, AFTER_DRAIN = false;
    const float* x0; const float* x1; float* out;
    __device__ __forceinline__ void operator()(const f32x4 (&acc)[2][2][4][2], const Unit& u, int wr, int wc, int fr, int fq) const {
        const int row0 = u.pm * BM + wr * 64 + fr, col0 = u.pn * BM + wc * 32 + 8 * fq;
        const float* xb = (row0 < MP) ? x0 + (size_t)row0 * DM : x1 + (size_t)(row0 - MP) * DM;
        float* ob = out + (size_t)row0 * DM;
#pragma unroll
        for (int ai = 0; ai < 2; ++ai)
#pragma unroll
            for (int m = 0; m < 4; ++m) { const size_t off = (size_t)(ai * HALF + m * 16) * DM + col0;
#pragma unroll
                for (int bj = 0; bj < 2; ++bj) { const f32x4 a0 = *(const f32x4*)(xb + off + bj * HALF), a1 = *(const f32x4*)(xb + off + bj * HALF + 4);
                    *(f32x4*)(ob + off + bj * HALF) = a0 + acc[ai][bj][m][0]; *(f32x4*)(ob + off + bj * HALF + 4) = a1 + acc[ai][bj][m][1]; } }
    }
};

template <class Epi, class Sched, bool ALIGN_EPI = false, bool SP2 = false>
__device__ __forceinline__ void gemm_phase(PG8_LAS unsigned char* lds, const Gemm g, const Sched& S, const Epi& E) {
    int tid_l = threadIdx.x; asm volatile("" : "+v"(tid_l));
    const int tid = tid_l, wid = __builtin_amdgcn_readfirstlane(tid >> 6), lane = tid & 63, wr = wid >> 2, wc = wid & 3, fr = lane & 15, fq = lane >> 4;
    const int K = g.K, nt = K / BK;
    unsigned voffA[2], voffB[2];
#pragma unroll
    for (int i = 0; i < 2; ++i) { int R, C; stage_rc(tid * 16 + i * 8192, R, C); const int Rb = Epi::PERM ? ((R & ~31) + perm32(R & 31)) : R;
        voffA[i] = (unsigned)(R * K + C) * 2u; voffB[i] = (unsigned)(Rb * K + C) * 2u; }
    const size_t kstep = (size_t)(BK * 2);
    const size_t hstep = (size_t)HALF * K * 2;
    const size_t tstep = 2 * hstep;
    const unsigned ldsw = (unsigned)wid * 1024u;
    const int aoff = lds_byte(wr * 64 + fr, fq * 8), boff = lds_byte(wc * 32 + fr, fq * 8);
#define PG8_SA(b, h) (((b) * 2 + (h)) * HTB)
#define PG8_SB(b, h) ((4 + (b) * 2 + (h)) * HTB)
#define PG8_STAGE(bufoff, gbase, voff) do { _Pragma("unroll") for (int _i = 0; _i < 2; ++_i) \
        __builtin_amdgcn_global_load_lds((const unsigned*)((const char*)(gbase) + (voff)[_i]), (PG8_LAS unsigned*)(lds + (bufoff) + ldsw + _i * 8192), 16, 0, 0); } while (0)
#define PG8_LDA(dst, b, h) do { _Pragma("unroll") for (int m = 0; m < 4; ++m) _Pragma("unroll") for (int k = 0; k < 2; ++k) dst[m][k] = *(const PG8_LAS bf16x8*)(lds + PG8_SA(b, h) + aoff + m * 2048 + k * 1024); } while (0)
#define PG8_LDB(dst, b, h) do { _Pragma("unroll") for (int n = 0; n < 2; ++n) _Pragma("unroll") for (int k = 0; k < 2; ++k) dst[n][k] = *(const PG8_LAS bf16x8*)(lds + PG8_SB(b, h) + boff + n * 2048 + k * 1024); } while (0)
#define PG8_MMA(ai, bj, At, Bt) do { __builtin_amdgcn_s_setprio(1); _Pragma("unroll") for (int m = 0; m < 4; ++m) _Pragma("unroll") for (int n = 0; n < 2; ++n) _Pragma("unroll") for (int k = 0; k < 2; ++k) \
        acc[ai][bj][m][n] = __builtin_amdgcn_mfma_f32_16x16x32_bf16(Bt[n][k], At[m][k], acc[ai][bj][m][n], 0, 0, 0); __builtin_amdgcn_s_setprio(0); } while (0)
#define PG8_WAIT_V(n) asm volatile("s_waitcnt vmcnt(" #n ")" ::: "memory")
#define PG8_WAIT_L(n) asm volatile("s_waitcnt lgkmcnt(" #n ")" ::: "memory")
#define PG8_BAR __builtin_amdgcn_s_barrier()
#define PG8_SCHED __builtin_amdgcn_sched_barrier(0)
    Unit cur, nxt; int ui = 0;
    if (!S.next(0, cur)) return;
    f32x4 acc[2][2][4][2];
#pragma unroll
    for (int a = 0; a < 2; ++a)
#pragma unroll
        for (int b = 0; b < 2; ++b)
#pragma unroll
            for (int m = 0; m < 4; ++m)
#pragma unroll
                for (int n = 0; n < 2; ++n) acc[a][b][m][n] = (f32x4){0.f, 0.f, 0.f, 0.f};
    bf16x8 At[4][2], B0[2][2], B1[2][2];
    const char* cA = (const char*)g.A + (size_t)cur.pm * tstep; const char* cB = (const char*)g.Bt + (size_t)cur.pn * tstep;
    S.a_ready(cur);
    if constexpr (SP2) {
        PG8_STAGE(PG8_SB(0, 0), cB, voffB); PG8_STAGE(PG8_SB(0, 1), cB + hstep, voffB); PG8_STAGE(PG8_SA(0, 0), cA, voffA); PG8_STAGE(PG8_SA(0, 1), cA + hstep, voffA);
        if (wr == 1) PG8_BAR;
        PG8_WAIT_V(2); PG8_BAR;
        PG8_STAGE(PG8_SB(1, 0), cB + kstep, voffB); PG8_STAGE(PG8_SA(1, 0), cA + kstep, voffA); PG8_STAGE(PG8_SB(1, 1), cB + hstep + kstep, voffB);
        PG8_WAIT_V(6); PG8_BAR;
    } else {
        PG8_STAGE(PG8_SB(0, 0), cB, voffB); PG8_STAGE(PG8_SA(0, 0), cA, voffA); PG8_STAGE(PG8_SB(0, 1), cB + hstep, voffB); PG8_STAGE(PG8_SA(0, 1), cA + hstep, voffA);
        if (wr == 1) PG8_BAR;
        PG8_WAIT_V(4); PG8_BAR;
        PG8_STAGE(PG8_SB(1, 0), cB + kstep, voffB); PG8_STAGE(PG8_SA(1, 0), cA + kstep, voffA); PG8_STAGE(PG8_SB(1, 1), cB + hstep + kstep, voffB);
        PG8_WAIT_V(6); PG8_BAR;
    }
    for (;;) {
        const bool has_next = S.next(ui + 1, nxt);
        const char* nA = has_next ? (const char*)g.A + (size_t)nxt.pm * tstep : cA; const char* nB = has_next ? (const char*)g.Bt + (size_t)nxt.pn * tstep : cB;
        for (int t = 0; t < nt; t += 2) {
            const bool last = (t == nt - 2);
            const char* a1 = cA + (size_t)(t + 1) * kstep;
            const char* a2 = last ? nA : cA + (size_t)(t + 2) * kstep; const char* b2 = last ? nB : cB + (size_t)(t + 2) * kstep;
            const char* a3 = a2 + kstep; const char* b3 = b2 + kstep;
            if (last && has_next) S.a_ready(nxt);
            if constexpr (SP2) {
            PG8_LDB(B0, 0, 0); PG8_LDB(B1, 0, 1); PG8_SCHED; PG8_LDA(At, 0, 0); PG8_STAGE(PG8_SA(1, 1), a1 + hstep, voffA);
            PG8_WAIT_V(8); PG8_WAIT_L(0); PG8_BAR; PG8_MMA(0, 0, At, B0); PG8_MMA(0, 1, At, B1); PG8_BAR; PG8_SCHED;
            PG8_LDA(At, 0, 1); PG8_STAGE(PG8_SB(0, 0), b2, voffB); PG8_STAGE(PG8_SB(0, 1), b2 + hstep, voffB); PG8_STAGE(PG8_SA(0, 0), a2, voffA);
            PG8_WAIT_V(8); PG8_WAIT_L(0); PG8_BAR; PG8_MMA(1, 0, At, B0); PG8_MMA(1, 1, At, B1); PG8_BAR; PG8_SCHED;
            PG8_LDB(B0, 1, 0); PG8_LDB(B1, 1, 1); PG8_SCHED; PG8_LDA(At, 1, 0); PG8_STAGE(PG8_SA(0, 1), a2 + hstep, voffA);
            PG8_WAIT_V(8); PG8_WAIT_L(0); PG8_BAR; PG8_MMA(0, 0, At, B0); PG8_MMA(0, 1, At, B1); PG8_BAR; PG8_SCHED;
            PG8_LDA(At, 1, 1); PG8_STAGE(PG8_SB(1, 0), b3, voffB); PG8_STAGE(PG8_SB(1, 1), b3 + hstep, voffB); PG8_STAGE(PG8_SA(1, 0), a3, voffA);
            PG8_WAIT_V(8); PG8_WAIT_L(0); PG8_BAR; PG8_MMA(1, 0, At, B0); PG8_MMA(1, 1, At, B1); PG8_BAR; PG8_SCHED;
            } else {
            PG8_LDB(B0, 0, 0); PG8_SCHED; PG8_LDA(At, 0, 0); PG8_STAGE(PG8_SA(1, 1), a1 + hstep, voffA);
            PG8_WAIT_L(8); PG8_BAR; PG8_WAIT_L(0); PG8_MMA(0, 0, At, B0); PG8_BAR; PG8_SCHED;
            PG8_LDB(B1, 0, 1); PG8_STAGE(PG8_SB(0, 0), b2, voffB);
            PG8_BAR; PG8_WAIT_L(0); PG8_MMA(0, 1, At, B1); PG8_BAR;
            PG8_LDA(At, 0, 1); PG8_STAGE(PG8_SA(0, 0), a2, voffA);
            PG8_BAR; PG8_WAIT_L(0); PG8_MMA(1, 0, At, B0); PG8_BAR; PG8_SCHED;
            PG8_STAGE(PG8_SB(0, 1), b2 + hstep, voffB);
            PG8_WAIT_V(6); PG8_BAR; PG8_MMA(1, 1, At, B1); PG8_BAR;
            PG8_LDB(B0, 1, 0); PG8_SCHED; PG8_LDA(At, 1, 0); PG8_STAGE(PG8_SA(0, 1), a2 + hstep, voffA);
            PG8_WAIT_L(8); PG8_BAR; PG8_WAIT_L(0); PG8_MMA(0, 0, At, B0); PG8_BAR; PG8_SCHED;
            PG8_LDB(B1, 1, 1); PG8_STAGE(PG8_SB(1, 0), b3, voffB);
            PG8_BAR; PG8_WAIT_L(0); PG8_MMA(0, 1, At, B1); PG8_BAR;
            PG8_LDA(At, 1, 1); PG8_STAGE(PG8_SA(1, 0), a3, voffA);
            PG8_BAR; PG8_WAIT_L(0); PG8_MMA(1, 0, At, B0); PG8_BAR; PG8_SCHED;
            PG8_STAGE(PG8_SB(1, 1), b3 + hstep, voffB);
            PG8_WAIT_V(6); PG8_BAR; PG8_MMA(1, 1, At, B1); PG8_BAR;
            }
        }
        if constexpr (ALIGN_EPI) { if (wr == 0) PG8_BAR; }
        if constexpr (!Epi::AFTER_DRAIN) { E(acc, cur, wr, wc, fr, fq); S.done(cur); }
        if (!has_next) break;
#pragma unroll
        for (int a = 0; a < 2; ++a)
#pragma unroll
            for (int b = 0; b < 2; ++b)
#pragma unroll
                for (int m = 0; m < 4; ++m)
#pragma unroll
                    for (int n = 0; n < 2; ++n) acc[a][b][m][n] = (f32x4){0.f, 0.f, 0.f, 0.f};
        cur = nxt; cA = nA; cB = nB; ++ui;
        if constexpr (ALIGN_EPI) { if (wr == 1) PG8_BAR; }
    }
    PG8_WAIT_V(0);
    if constexpr (!ALIGN_EPI) { if (wr == 0) PG8_BAR; }
    PG8_BAR;
    if constexpr (Epi::AFTER_DRAIN) { E.fused(acc, cur, wr, wc, fr, fq, lds, wid, lane); S.done(cur); }
#undef PG8_SA
#undef PG8_SB
#undef PG8_STAGE
#undef PG8_LDA
#undef PG8_LDB
#undef PG8_MMA
#undef PG8_WAIT_V
#undef PG8_WAIT_L
#undef PG8_BAR
#undef PG8_SCHED
}
}

#define LAS __attribute__((address_space(3)))
typedef unsigned short bf16_t;
typedef short bf16x8 __attribute__((ext_vector_type(8)));
typedef short s16x4 __attribute__((ext_vector_type(4)));
typedef float f32x4 __attribute__((ext_vector_type(4)));
typedef float f32x16 __attribute__((ext_vector_type(16)));
typedef unsigned u32x4 __attribute__((ext_vector_type(4)));
typedef unsigned u32x2 __attribute__((ext_vector_type(2)));
constexpr int NWAVES = 8, NTHREADS = 512;
constexpr int LDS_BYTES = 139264;
__device__ __forceinline__ unsigned pk_bf16(float lo, float hi) { unsigned r; asm volatile("v_cvt_pk_bf16_f32 %0, %1, %2" : "=v"(r) : "v"(lo), "v"(hi)); return r; }
__device__ __forceinline__ float bf_lo(unsigned w) { return __uint_as_float(w << 16); }
__device__ __forceinline__ float bf_hi(unsigned w) { return __uint_as_float(w & 0xffff0000u); }

constexpr size_t WS_CTL = 0, CTL_BYTES = 4096;
constexpr size_t WS_TAB = 65536;
constexpr int TABA_W = 513, TABC_W = 385, TABA_N = 12 * TABA_W, TABC_N = 24 * TABC_W, ROPE_N = 64 * 16 * 2;
constexpr size_t WS_WIN = 1u << 20;
constexpr size_t WS_WOUT = WS_WIN + (size_t)2 * NP * DM * 2;
constexpr size_t WS_H = WS_WOUT + (size_t)2 * DM * DM * 2;
constexpr size_t WS_P = WS_H + (size_t)MT * DM * 2;
constexpr size_t WS_CS = WS_P + (size_t)MT * NP * 2;
constexpr size_t WS_LSE = WS_CS + (size_t)3 * MT * 512 * 2;
constexpr size_t WS_END = WS_LSE + (size_t)3 * MT * 8 * 4;

__constant__ float INVF[16] = {1.0f, 0.5623413251903491f, 0.31622776601683794f, 0.1778279410038923f, 0.1f, 0.05623413251903491f, 0.03162277660168379f, 0.01778279410038923f,
                               0.01f, 0.005623413251903491f, 0.0031622776601683794f, 0.0017782794100389228f, 0.001f, 0.0005623413251903491f, 0.00031622776601683794f, 0.00017782794100389227f};

struct Params {
    const float* x_prompt; const float* x_sample; const float* ln_g; const float* w_in; const float* qna; const float* kna; const float* sink; const float* qnb; const float* knb;
    const float* qnc; const float* knc; const float* rel_bias; const float* w_out; float* out; unsigned char* ws;
};

__device__ __forceinline__ int t5_bucket(int rel) {
    const int n = rel < 0 ? -rel : rel;
    const int large = 8 + (n >= 15) + (n >= 27) + (n >= 50) + (n >= 91) + (n >= 166) + (n >= 305) + (n >= 559);
    return (rel > 0 ? 16 : 0) + (n < 8 ? n : large);
}
template <bool PERMUTE>
__device__ __forceinline__ void transpose_item(const float* W, int K, int N, bf16_t* WT, LAS float* scr, int item, int lane) {
    const int nblk = N / 32, kb = item / nblk, nb = item % nblk, k0 = 64 * kb, n0 = 32 * nb;
    float wv[32];
#pragma unroll
    for (int i = 0; i < 32; ++i) wv[i] = W[(size_t)(k0 + 2 * i + (lane >> 5)) * N + n0 + (lane & 31)];
#pragma unroll
    for (int i = 0; i < 32; ++i) scr[(2 * i + (lane >> 5)) * 33 + (lane & 31)] = wv[i];
    asm volatile("s_waitcnt lgkmcnt(0)" ::: "memory");
    const int c = lane & 7;
    const int r0 = PERMUTE ? (256 * (n0 >> 8) + 128 * ((n0 >> 5) & 1) + 32 * ((n0 >> 6) & 3)) : n0;
#pragma unroll
    for (int j = 0; j < 4; ++j) { const int n = (lane >> 3) + 8 * j; const LAS float* s = scr + (8 * c) * 33 + n;
        u32x4 o; o.x = pk_bf16(s[0 * 33], s[1 * 33]); o.y = pk_bf16(s[2 * 33], s[3 * 33]); o.z = pk_bf16(s[4 * 33], s[5 * 33]); o.w = pk_bf16(s[6 * 33], s[7 * 33]);
        *(u32x4*)(WT + (size_t)(r0 + n) * K + k0 + 8 * c) = o; }
    asm volatile("s_waitcnt lgkmcnt(0)" ::: "memory");
}
__device__ __forceinline__ void prologue_phase(const Params& p, LAS unsigned char* lds, int tid, int wave, int lane) {
    LAS float* scr = (LAS float*)(lds + wave * 16384);
    const int gw = blockIdx.x * NWAVES + wave, NGW = gridDim.x * NWAVES;
    constexpr int I_IN = (DM / 64) * (NP / 32), I_OUT = (DM / 64) * (DM / 32);
    bf16_t* win = (bf16_t*)(p.ws + WS_WIN); bf16_t* wout = (bf16_t*)(p.ws + WS_WOUT);
    for (int it = gw; it < 2 * (I_IN + I_OUT); it += NGW) {
        int r = it;
        if (r < 2 * I_IN) { const int l = r / I_IN; r -= l * I_IN; transpose_item<true>(p.w_in + (size_t)l * DM * NP, DM, NP, win + (size_t)l * NP * DM, scr, r, lane); }
        else { r -= 2 * I_IN; const int l = r / I_OUT; r -= l * I_OUT; transpose_item<false>(p.w_out + (size_t)l * DM * DM, DM, DM, wout + (size_t)l * DM * DM, scr, r, lane); }
    }
    float* tab = (float*)(p.ws + WS_TAB);
    for (int i = blockIdx.x * NTHREADS + tid; i < TABA_N + TABC_N + ROPE_N / 2; i += gridDim.x * NTHREADS) {
        if (i < TABA_N) { const int h = i / TABA_W, rel = i % TABA_W - 256; tab[i] = (rel >= -128 && rel <= 128) ? p.rel_bias[t5_bucket(rel) * 36 + h] * LOG2E : -INFINITY; }
        else if (i < TABA_N + TABC_N) { const int j = i - TABA_N, gh = j / TABC_W, rel = j % TABC_W - 192, g = gh >> 3; const int dil = (g == 0) ? 1 : (g == 1 ? 4 : 16);
            tab[i] = (rel >= -64 && rel <= 64) ? p.rel_bias[t5_bucket(rel * dil) * 36 + 12 + gh] * LOG2E : -INFINITY; }
        else { const int j = i - TABA_N - TABC_N, pos = j >> 4, f = j & 15; const float ang = (float)pos * INVF[f];
            tab[TABA_N + TABC_N + 2 * j] = cosf(ang); tab[TABA_N + TABC_N + 2 * j + 1] = sinf(ang); }
    }
}
__device__ __forceinline__ void norm_phase(const float* x0, const float* x1, const float* g, bf16_t* H, int wave, int lane) {
    const int gw = blockIdx.x * NWAVES + wave, NGW = gridDim.x * NWAVES;
    f32x4 nx[8];
    { const f32x4* xr = (const f32x4*)((gw < MP) ? x0 + (size_t)gw * DM : x1 + (size_t)(gw - MP) * DM) + lane;
#pragma unroll
      for (int j = 0; j < 8; ++j) nx[j] = xr[64 * j]; }
    for (int row = gw; row < MT; row += NGW) {
        f32x4 v[8]; float s = 0.f;
#pragma unroll
        for (int j = 0; j < 8; ++j) v[j] = nx[j];
        const int nr = row + NGW;
        if (nr < MT) { const f32x4* xr = (const f32x4*)((nr < MP) ? x0 + (size_t)nr * DM : x1 + (size_t)(nr - MP) * DM) + lane;
#pragma unroll
            for (int j = 0; j < 8; ++j) nx[j] = xr[64 * j]; }
#pragma unroll
        for (int j = 0; j < 8; ++j) s += (v[j][0] * v[j][0] + v[j][1] * v[j][1]) + (v[j][2] * v[j][2] + v[j][3] * v[j][3]);
#pragma unroll
        for (int o = 1; o < 64; o <<= 1) s += __shfl_xor(s, o);
        const float rs = 1.0f / sqrtf(s * (1.0f / DM) + RMS_EPS);
        u32x2* o8 = (u32x2*)(H + (size_t)row * DM) + lane;
#pragma unroll
        for (int j = 0; j < 8; ++j) { const f32x4 gv = ((const f32x4*)g)[lane + 64 * j]; u32x2 o;
            o.x = pk_bf16(v[j][0] * rs * gv[0], v[j][1] * rs * gv[1]); o.y = pk_bf16(v[j][2] * rs * gv[2], v[j][3] * rs * gv[3]); o8[64 * j] = o; }
    }
}

namespace att {
constexpr int KP = 144, VP = 192, KBUF = 64 * KP, VBUF = 64 * VP, BUFB = KBUF + VBUF;
constexpr int L_TAB = 2 * BUFB, L_SLOT = L_TAB + (TABA_N + TABC_N) * 4;
static_assert(L_SLOT + 64 <= LDS_BYTES, "attention LDS map");
constexpr int N_BS = 768, N_BP = 192, N_A = 960, N_C = 1920, N_UNITS = N_BS + N_BP + N_A + N_C;
constexpr float THR = 5.0f;
typedef short v4i16_t __attribute__((ext_vector_type(4)));
__device__ __forceinline__ s16x4 vtr(const LAS unsigned char* p) { return __builtin_bit_cast(s16x4, __builtin_amdgcn_ds_read_tr16_b64_v4i16((LAS v4i16_t*)p)); }
#define MFMA32(a, b, c) __builtin_amdgcn_mfma_f32_32x32x16_bf16((a), (b), (c), 0, 0, 0)

struct UnitP { int rowbase, dil, rho, i0, t_lo, t_hi, qcol, kcol, vcol, gcol, ocol, tabidx, g, kvi; };

__device__ __forceinline__ void softmax_step(f32x16& p0, f32x16& p1, float& m, float& l, f32x16& o0, f32x16& o1) {
    float a = fmaxf(fmaxf(p0[0], p0[1]), p1[0]), b = fmaxf(fmaxf(p0[2], p0[3]), p1[1]); a = fmaxf(fmaxf(a, p1[2]), p1[3]);
#pragma unroll
    for (int r = 4; r < 16; r += 4) { a = fmaxf(fmaxf(a, p0[r]), p0[r + 1]); b = fmaxf(fmaxf(b, p0[r + 2]), p0[r + 3]); a = fmaxf(fmaxf(a, p1[r]), p1[r + 1]); b = fmaxf(fmaxf(b, p1[r + 2]), p1[r + 3]); }
    float rm = fmaxf(a, b);
    { auto rr = __builtin_amdgcn_permlane32_swap(__float_as_uint(rm), __float_as_uint(rm), false, false); rm = fmaxf(__uint_as_float(rr[0]), __uint_as_float(rr[1])); }
    if (__any(rm > m + THR)) { const float mn = fmaxf(m, rm), al = __builtin_amdgcn_exp2f(m - mn); m = mn; l *= al; o0 = o0 * al; o1 = o1 * al; }
    float ls0 = 0.f, ls1 = 0.f;
#pragma unroll
    for (int r = 0; r < 16; ++r) { p0[r] = __builtin_amdgcn_exp2f(p0[r] - m); p1[r] = __builtin_amdgcn_exp2f(p1[r] - m); ls0 += p0[r]; ls1 += p1[r]; }
    l += ls0 + ls1;
}
__device__ __forceinline__ bf16x8 pack8(const f32x16& x, int s) {
    u32x4 w; w.x = pk_bf16(x[8 * s], x[8 * s + 1]); w.y = pk_bf16(x[8 * s + 2], x[8 * s + 3]); w.z = pk_bf16(x[8 * s + 4], x[8 * s + 5]); w.w = pk_bf16(x[8 * s + 6], x[8 * s + 7]);
    return __builtin_bit_cast(bf16x8, w);
}
template <int MODE>
__device__ __forceinline__ void store_block(const Params& p, const UnitP& u, const f32x16& o0, const f32x16& o1, float m, float l, float m_sink, size_t qrow, int hq, int hi) {
    const bf16_t* __restrict__ P = (const bf16_t*)(p.ws + WS_P);
    float lt; { auto rr = __builtin_amdgcn_permlane32_swap(__float_as_uint(l), __float_as_uint(l), false, false); lt = __uint_as_float(rr[0]) + __uint_as_float(rr[1]); }
    if (MODE == 0) lt += __builtin_amdgcn_exp2f(m_sink - m);
    const float inv = __builtin_amdgcn_rcpf(lt);
    if (MODE != 2) {
        bf16_t* mix = (bf16_t*)(p.ws + WS_H) + qrow * DM + u.ocol + hq * 64 + 4 * hi;
        const bf16_t* gp = P + qrow * NP + u.gcol + hq * 64 + 4 * hi;
#pragma unroll
        for (int g = 0; g < 4; ++g) {
            const u32x2 g0 = *(const u32x2*)(gp + 8 * g), g1 = *(const u32x2*)(gp + 32 + 8 * g); u32x2 w0, w1;
            w0.x = pk_bf16(o0[4 * g] * inv * bf_lo(g0.x), o0[4 * g + 1] * inv * bf_hi(g0.x)); w0.y = pk_bf16(o0[4 * g + 2] * inv * bf_lo(g0.y), o0[4 * g + 3] * inv * bf_hi(g0.y));
            w1.x = pk_bf16(o1[4 * g] * inv * bf_lo(g1.x), o1[4 * g + 1] * inv * bf_hi(g1.x)); w1.y = pk_bf16(o1[4 * g + 2] * inv * bf_lo(g1.y), o1[4 * g + 3] * inv * bf_hi(g1.y));
            *(u32x2*)(mix + 8 * g) = w0; *(u32x2*)(mix + 32 + 8 * g) = w1;
        }
    } else {
        bf16_t* cs = (bf16_t*)(p.ws + WS_CS) + ((size_t)u.g * MT + qrow) * 512 + (u.kvi * 4 + hq) * 64 + 4 * hi;
#pragma unroll
        for (int g = 0; g < 4; ++g) { u32x2 w0, w1;
            w0.x = pk_bf16(o0[4 * g] * inv, o0[4 * g + 1] * inv); w0.y = pk_bf16(o0[4 * g + 2] * inv, o0[4 * g + 3] * inv);
            w1.x = pk_bf16(o1[4 * g] * inv, o1[4 * g + 1] * inv); w1.y = pk_bf16(o1[4 * g + 2] * inv, o1[4 * g + 3] * inv);
            *(u32x2*)(cs + 8 * g) = w0; *(u32x2*)(cs + 32 + 8 * g) = w1; }
        if (hi == 0) ((float*)(p.ws + WS_LSE))[((size_t)u.g * MT + qrow) * 8 + u.kvi * 4 + hq] = m + __builtin_amdgcn_logf(lt);
    }
}
template <int MODE, bool SEQ>
__device__ __forceinline__ void tile_loop(const UnitP& u, const bf16_t* kg, const bf16_t* vg, size_t tstep, u32x4 kreg, u32x4 vreg, LAS unsigned char* kst, LAS unsigned char* vst,
                                          const LAS unsigned char* krd, const LAS unsigned char* vrd, const LAS float* btab, int iqa, int hi, int wt_lo, int wt_hi,
                                          const bf16x8 (&qa)[4], const bf16x8 (&qb)[4], float& ma, float& la, float& mb, float& lb, f32x16& oa0, f32x16& oa1, f32x16& ob0, f32x16& ob1) {
    for (int t = u.t_lo; t <= u.t_hi; ++t) {
        const int boff = ((t - u.t_lo) & 1) * BUFB;
        __syncthreads();
        if (t < u.t_hi) { kreg = *(const u32x4*)(kg + (size_t)(t + 1) * tstep); vreg = *(const u32x4*)(vg + (size_t)(t + 1) * tstep); }
        if (MODE == 1 || (t >= wt_lo && t <= wt_hi)) {
          const LAS float* bt = btab + (64 * t - iqa + 4 * hi);
          if (!SEQ) {
            f32x16 pa0 = {}, pa1 = {}, pb0 = {}, pb1 = {};
#pragma unroll
            for (int ds = 0; ds < 4; ++ds) {
                const bf16x8 k0 = *(const LAS bf16x8*)(krd + boff + ds * 32), k1 = *(const LAS bf16x8*)(krd + boff + 32 * KP + ds * 32);
                pa0 = MFMA32(k0, qa[ds], pa0); pa1 = MFMA32(k1, qa[ds], pa1); pb0 = MFMA32(k0, qb[ds], pb0); pb1 = MFMA32(k1, qb[ds], pb1);
            }
            __builtin_amdgcn_sched_barrier(0);
            if (MODE != 1) {
#pragma unroll
                for (int r = 0; r < 16; ++r) { const int o = (r & 3) + 8 * (r >> 2);
                    pa0[r] += bt[o]; pa1[r] += bt[o + 32]; pb0[r] += bt[o - 32]; pb1[r] += bt[o]; }
            }
            softmax_step(pa0, pa1, ma, la, oa0, oa1);
            softmax_step(pb0, pb1, mb, lb, ob0, ob1);
            __builtin_amdgcn_sched_barrier(0);
#pragma unroll
            for (int s = 0; s < 4; ++s) {
                const bf16x8 xa = (s < 2) ? pack8(pa0, s & 1) : pack8(pa1, s & 1), xb = (s < 2) ? pack8(pb0, s & 1) : pack8(pb1, s & 1);
                const LAS unsigned char* vb = vrd + boff + s * 16 * VP;
                const s16x4 a0 = vtr(vb), a1 = vtr(vb + 8 * VP), b0 = vtr(vb + 64), b1 = vtr(vb + 8 * VP + 64);
                const bf16x8 vf0 = __builtin_shufflevector(a0, a1, 0, 1, 2, 3, 4, 5, 6, 7), vf1 = __builtin_shufflevector(b0, b1, 0, 1, 2, 3, 4, 5, 6, 7);
                oa0 = MFMA32(vf0, xa, oa0); oa1 = MFMA32(vf1, xa, oa1); ob0 = MFMA32(vf0, xb, ob0); ob1 = MFMA32(vf1, xb, ob1);
                if (s == 1) __builtin_amdgcn_sched_barrier(0);
            }
          } else {
#define ATT_ONE_BLOCK(QF, M_, L_, O0, O1, BOFS) do { \
            f32x16 p0 = {}, p1 = {}; \
            _Pragma("unroll") for (int ds = 0; ds < 4; ++ds) { \
                const bf16x8 k0 = *(const LAS bf16x8*)(krd + boff + ds * 32), k1 = *(const LAS bf16x8*)(krd + boff + 32 * KP + ds * 32); \
                p0 = MFMA32(k0, QF[ds], p0); p1 = MFMA32(k1, QF[ds], p1); } \
            __builtin_amdgcn_sched_barrier(0); \
            if (MODE != 1) { _Pragma("unroll") for (int r = 0; r < 16; ++r) { const int o = (r & 3) + 8 * (r >> 2); p0[r] += bt[o + (BOFS)]; p1[r] += bt[o + 32 + (BOFS)]; } } \
            softmax_step(p0, p1, M_, L_, O0, O1); \
            __builtin_amdgcn_sched_barrier(0); \
            _Pragma("unroll") for (int s = 0; s < 4; ++s) { \
                const bf16x8 xs = (s < 2) ? pack8(p0, s & 1) : pack8(p1, s & 1); \
                const LAS unsigned char* vb = vrd + boff + s * 16 * VP; \
                const s16x4 a0 = vtr(vb), a1 = vtr(vb + 8 * VP), b0 = vtr(vb + 64), b1 = vtr(vb + 8 * VP + 64); \
                const bf16x8 vf0 = __builtin_shufflevector(a0, a1, 0, 1, 2, 3, 4, 5, 6, 7), vf1 = __builtin_shufflevector(b0, b1, 0, 1, 2, 3, 4, 5, 6, 7); \
                O0 = MFMA32(vf0, xs, O0); O1 = MFMA32(vf1, xs, O1); } \
            __builtin_amdgcn_sched_barrier(0); } while (0)
            ATT_ONE_BLOCK(qa, ma, la, oa0, oa1, 0);
            ATT_ONE_BLOCK(qb, mb, lb, ob0, ob1, -32);
#undef ATT_ONE_BLOCK
          }
        }
        if (t < u.t_hi) { *(LAS u32x4*)(kst + (BUFB - boff)) = kreg; *(LAS u32x4*)(vst + (BUFB - boff)) = vreg; }
    }
}
template <int MODE>
__device__ __forceinline__ void unit(LAS unsigned char* lds, const Params& p, const UnitP& u, int tid, int wave, int lane) {
    const bf16_t* __restrict__ P = (const bf16_t*)(p.ws + WS_P);
    const int r32 = lane & 31, hi = lane >> 5, hq = wave >> 1, sub = wave & 1;
    const int iqa = u.i0 + 64 * sub + r32;
    const size_t qrow_a = (size_t)(u.rowbase + u.rho + u.dil * iqa), qrow_b = qrow_a + (size_t)(32 * u.dil);
    constexpr int W = (MODE == 0) ? 128 : 64, TW = (MODE == 0) ? TABA_W : TABC_W, TC = (MODE == 0) ? 256 : 192;
    const int kk = tid >> 3, ch = tid & 7;
    const bf16_t* kg = P + (size_t)(u.rowbase + u.rho + u.dil * kk) * NP + u.kcol + ch * 8;
    const bf16_t* vg = P + (size_t)(u.rowbase + u.rho + u.dil * kk) * NP + u.vcol + ch * 8;
    const size_t tstep = (size_t)64 * u.dil * NP;
    u32x4 kreg = *(const u32x4*)(kg + (size_t)u.t_lo * tstep), vreg = *(const u32x4*)(vg + (size_t)u.t_lo * tstep);
    bf16x8 qa[4], qb[4];
#pragma unroll
    for (int ds = 0; ds < 4; ++ds) { qa[ds] = *(const bf16x8*)(P + qrow_a * NP + u.qcol + hq * 64 + ds * 16 + hi * 8); qb[ds] = *(const bf16x8*)(P + qrow_b * NP + u.qcol + hq * 64 + ds * 16 + hi * 8); }
    LAS unsigned char* kst = lds + kk * KP + ch * 16; LAS unsigned char* vst = lds + KBUF + kk * VP + ch * 16;
    *(LAS u32x4*)kst = kreg; *(LAS u32x4*)vst = vreg;
    asm volatile("" :: "v"(qa[0]), "v"(qa[1]), "v"(qa[2]), "v"(qa[3]), "v"(qb[0]), "v"(qb[1]), "v"(qb[2]), "v"(qb[3]));
    const LAS unsigned char* krd = lds + r32 * KP + hi * 16;
    const LAS unsigned char* vrd = lds + KBUF + (4 * hi + ((lane & 15) >> 2)) * VP + ((lane >> 4) & 1) * 32 + (lane & 3) * 8;
    const LAS float* btab = (const LAS float*)(lds + L_TAB) + u.tabidx + hq * TW + TC;
    float m_sink = -1e30f;
    if (MODE == 0) m_sink = p.sink[u.g * 12 + u.kvi * 4 + hq] * LOG2E;
    float ma = m_sink, mb = m_sink, la = 0.f, lb = 0.f;
    f32x16 oa0 = {}, oa1 = {}, ob0 = {}, ob1 = {};
    int wt_lo = u.t_lo, wt_hi = u.t_hi;
    if (MODE != 1) { const int c = (u.i0 >> 6) + sub; wt_lo = c - W / 64 > wt_lo ? c - W / 64 : wt_lo; wt_hi = c + W / 64 < wt_hi ? c + W / 64 : wt_hi; }
    if (true) tile_loop<MODE, false>(u, kg, vg, tstep, kreg, vreg, kst, vst, krd, vrd, btab, iqa, hi, wt_lo, wt_hi, qa, qb, ma, la, mb, lb, oa0, oa1, ob0, ob1);
    else tile_loop<MODE, true>(u, kg, vg, tstep, kreg, vreg, kst, vst, krd, vrd, btab, iqa, hi, wt_lo, wt_hi, qa, qb, ma, la, mb, lb, oa0, oa1, ob0, ob1);
    store_block<MODE>(p, u, oa0, oa1, ma, la, m_sink, qrow_a, hq, hi);
    store_block<MODE>(p, u, ob0, ob1, mb, lb, m_sink, qrow_b, hq, hi);
}

__device__ __forceinline__ void seqblk_decode(int sb, int& rowbase, int& S, int& blk) {
    if (sb < 256) { rowbase = MP + (sb >> 5) * 4096; S = 4096; blk = sb & 31; } else { sb -= 256; rowbase = (sb >> 4) * 2048; S = 2048; blk = sb & 15; }
}
__device__ __forceinline__ void phase(LAS unsigned char* lds, const Params& p, int layer, int cslot, int ubeg, int uend, int tid, int wave, int lane) {
    { const float* gt = (const float*)(p.ws + WS_TAB); LAS float* lt = (LAS float*)(lds + L_TAB);
      for (int i = tid; i < TABA_N + TABC_N; i += NTHREADS) lt[i] = gt[i]; }
    unsigned* ctr = (unsigned*)(p.ws + WS_CTL) + 64 * cslot;
    volatile LAS int* slot = (volatile LAS int*)(lds + L_SLOT);
    int nxt = 0;
    if (tid == 0) { nxt = ubeg + (int)atomicAdd(ctr, 1u); *slot = nxt; }
    __syncthreads();
    int un = *slot;
    while (un < uend) {
        if (tid == 0) nxt = ubeg + (int)atomicAdd(ctr, 1u);
        UnitP u; u.dil = 1; u.rho = 0; u.g = 0; u.kvi = 0; u.tabidx = 0; u.gcol = 0; u.ocol = 0;
        if (un < N_BS + N_BP) {
            int b, kvh, blk, S;
            if (un < N_BS) { b = un / 96; const int rem = un % 96; kvh = rem >> 5; blk = rem & 31; u.rowbase = MP + b * 4096; S = 4096; }
            else { const int v = un - N_BS; b = v / 48; const int rem = v % 48; kvh = rem >> 4; blk = rem & 15; u.rowbase = b * 2048; S = 2048; }
            u.i0 = blk * 128; u.t_lo = 0; u.t_hi = S / 64 - 1; u.qcol = C_QB + kvh * 256; u.kcol = C_KB + kvh * 64; u.vcol = C_VB + kvh * 64; u.gcol = C_GB + kvh * 256; u.ocol = 768 + kvh * 256;
            unit<1>(lds, p, u, tid, wave, lane);
        } else if (un < N_BS + N_BP + N_A) {
            const int v = un - (N_BS + N_BP), sb = v / 3, kvh = v % 3; int S, blk; seqblk_decode(sb, u.rowbase, S, blk);
            u.i0 = blk * 128; u.t_lo = 2 * blk - 2 < 0 ? 0 : 2 * blk - 2; u.t_hi = 2 * blk + 3 > S / 64 - 1 ? S / 64 - 1 : 2 * blk + 3;
            u.qcol = C_QA + kvh * 256; u.kcol = C_KA + kvh * 64; u.vcol = C_VA + kvh * 64; u.gcol = C_GA + kvh * 256; u.ocol = kvh * 256; u.tabidx = kvh * 4 * TABA_W; u.g = layer; u.kvi = kvh;
            unit<0>(lds, p, u, tid, wave, lane);
        } else {
            const int v = un - (N_BS + N_BP + N_A), g = v / 640, r = v % 640, sb = r >> 1, kvi = r & 1; int S, blk; seqblk_decode(sb, u.rowbase, S, blk);
            const int dsh = 2 * g, nb = (S >> dsh) >> 7;
            u.dil = 1 << dsh; u.rho = blk / nb; const int lb = blk % nb; u.i0 = lb * 128; u.t_lo = 2 * lb - 1 < 0 ? 0 : 2 * lb - 1; u.t_hi = 2 * lb + 2 > 2 * nb - 1 ? 2 * nb - 1 : 2 * lb + 2;
            u.qcol = C_QC + (g * 8 + kvi * 4) * 64; u.kcol = C_KC + (g * 2 + kvi) * 64; u.vcol = C_VC + (g * 2 + kvi) * 64; u.tabidx = TABA_N + (g * 8 + kvi * 4) * TABC_W; u.g = g; u.kvi = kvi;
            unit<2>(lds, p, u, tid, wave, lane);
        }
        __syncthreads();
        if (tid == 0) *slot = nxt;
        __syncthreads();
        un = *slot;
    }
}
__device__ __forceinline__ void combine_one(const bf16_t* cs, const float* lse, const bf16_t* P, bf16_t* mix, size_t i) {
    const size_t row = i >> 6; const int hc = (int)(i >> 3) & 7, chk = (int)i & 7;
    const float l0 = lse[row * 8 + hc], l1 = lse[((size_t)MT + row) * 8 + hc], l2 = lse[((size_t)2 * MT + row) * 8 + hc];
    const u32x4 a = *(const u32x4*)(cs + row * 512 + hc * 64 + chk * 8), b = *(const u32x4*)(cs + ((size_t)MT + row) * 512 + hc * 64 + chk * 8),
                c = *(const u32x4*)(cs + ((size_t)2 * MT + row) * 512 + hc * 64 + chk * 8), gt = *(const u32x4*)(P + row * NP + C_GC + hc * 64 + chk * 8);
    const float mx = fmaxf(l0, fmaxf(l1, l2));
    float w0 = __builtin_amdgcn_exp2f(l0 - mx), w1 = __builtin_amdgcn_exp2f(l1 - mx), w2 = __builtin_amdgcn_exp2f(l2 - mx);
    const float inv = 1.0f / (w0 + w1 + w2); w0 *= inv; w1 *= inv; w2 *= inv;
    u32x4 o;
#pragma unroll
    for (int k = 0; k < 4; ++k) {
        const float lo = (w0 * bf_lo(a[k]) + w1 * bf_lo(b[k]) + w2 * bf_lo(c[k])) * bf_lo(gt[k]), hi = (w0 * bf_hi(a[k]) + w1 * bf_hi(b[k]) + w2 * bf_hi(c[k])) * bf_hi(gt[k]);
        o[k] = pk_bf16(lo, hi);
    }
    *(u32x4*)(mix + row * DM + 1536 + hc * 64 + chk * 8) = o;
}
__device__ __forceinline__ void combine_phase(const Params& p, int tid) {
    const bf16_t* cs = (const bf16_t*)(p.ws + WS_CS); const float* lse = (const float*)(p.ws + WS_LSE);
    const bf16_t* P = (const bf16_t*)(p.ws + WS_P); bf16_t* mix = (bf16_t*)(p.ws + WS_H);
    const size_t stride = (size_t)gridDim.x * NTHREADS, total = (size_t)MT * 64;
    size_t i = (size_t)blockIdx.x * NTHREADS + tid;
    for (; i + 3 * stride < total; i += 4 * stride) { combine_one(cs, lse, P, mix, i); combine_one(cs, lse, P, mix, i + stride); combine_one(cs, lse, P, mix, i + 2 * stride); combine_one(cs, lse, P, mix, i + 3 * stride); }
    for (; i < total; i += stride) combine_one(cs, lse, P, mix, i);
}
}

typedef const __attribute__((address_space(4))) Params* KParamsPtr;
__device__ __forceinline__ Params fresh_params() {
#if defined(__HIP_DEVICE_COMPILE__)
    KParamsPtr pp = (KParamsPtr)__builtin_amdgcn_kernarg_segment_ptr(); asm volatile("" : "+s"(pp)); Params r;
    r.x_prompt = pp->x_prompt; r.x_sample = pp->x_sample; r.ln_g = pp->ln_g; r.w_in = pp->w_in; r.qna = pp->qna; r.kna = pp->kna; r.sink = pp->sink; r.qnb = pp->qnb; r.knb = pp->knb;
    r.qnc = pp->qnc; r.knc = pp->knc; r.rel_bias = pp->rel_bias; r.w_out = pp->w_out; r.out = pp->out; r.ws = pp->ws; return r;
#else
    return Params{};
#endif
}
#define PHASE_IDS() int tid_l = threadIdx.x; asm volatile("" : "+v"(tid_l)); const int tid = tid_l, lane = tid & 63, wave = __builtin_amdgcn_readfirstlane(tid >> 6); (void)lane; (void)wave
__global__ void __launch_bounds__(NTHREADS, 2) fwd_megakernel(Params p_unused) {
    extern __shared__ __attribute__((aligned(16))) unsigned char lds_raw[];
    LAS unsigned char* lds = (LAS unsigned char*)lds_raw;
#ifndef NO_PRO
    { const Params p = fresh_params(); PHASE_IDS(); prologue_phase(p, lds, tid, wave, lane); }
#endif
    for (int layer = 0; layer < 2; ++layer) {
        asm volatile("" : "+s"(layer));
#ifndef NO_NORM
        { const Params p = fresh_params(); PHASE_IDS();
          const float* x0 = layer == 0 ? p.x_prompt : p.out; const float* x1 = layer == 0 ? p.x_sample : p.out + (size_t)MP * DM;
          norm_phase(x0, x1, p.ln_g + layer * DM, (bf16_t*)(p.ws + WS_H), wave, lane); }
#endif
        cg::this_grid().sync();
#if defined(NAIVE_G1)
        { const Params p = fresh_params(); PHASE_IDS(); naive_g1(p, layer, wave, lane); }
#endif
#if defined(NAIVE_G2X)
#endif
#ifndef NO_G1
        { const Params p = fresh_params();
          pg8::Gemm g{(const bf16_t*)(p.ws + WS_H), (const bf16_t*)(p.ws + WS_WIN) + (size_t)layer * NP * DM, MT, NP, DM}; pg8::StaticOrder S; S.init(MT, NP, (int)gridDim.x, (int)blockIdx.x);
          pg8::EpiProj E{(bf16_t*)(p.ws + WS_P), p.qna + layer * 64, p.kna + layer * 64, p.qnb + layer * 64, p.knb + layer * 64, p.qnc + layer * 64, p.knc + layer * 64, (const float*)(p.ws + WS_TAB) + TABA_N + TABC_N};
          pg8::gemm_phase<pg8::EpiProj, pg8::StaticOrder, true, true>(lds, g, S, E);
#if defined(REP_G1)
          pg8::gemm_phase<pg8::EpiProj, pg8::StaticOrder, true, true>(lds, g, S, E);
#endif
        }
#endif
        cg::this_grid().sync();
#ifndef NO_ATT
        { const Params p = fresh_params(); PHASE_IDS(); att::phase(lds, p, layer, layer, 0, att::N_UNITS, tid, wave, lane); }
#if defined(REP_ATT)
        cg::this_grid().sync();
        { const Params p = fresh_params(); PHASE_IDS(); att::phase(lds, p, layer, layer + 2, REP_ATT_LO, REP_ATT_HI, tid, wave, lane); }
#endif
#endif
        cg::this_grid().sync();
#ifndef NO_CMB
        { const Params p = fresh_params(); PHASE_IDS(); att::combine_phase(p, tid); }
#endif
        cg::this_grid().sync();
#if defined(NAIVE_MASK)
        { const Params p = fresh_params(); PHASE_IDS(); naive_attention(p, layer, wave, lane); }
        cg::this_grid().sync();
#endif
#if defined(NAIVE_G2)
        { const Params p = fresh_params(); PHASE_IDS(); naive_g2(p, layer, wave, lane); }
#endif
#ifndef NO_G2
        { const Params p = fresh_params();
          const float* x0 = layer == 0 ? p.x_prompt : p.out; const float* x1 = layer == 0 ? p.x_sample : p.out + (size_t)MP * DM;
          pg8::Gemm g{(const bf16_t*)(p.ws + WS_H), (const bf16_t*)(p.ws + WS_WOUT) + (size_t)layer * DM * DM, MT, DM, DM}; pg8::StaticOrder S; S.init(MT, DM, (int)gridDim.x, (int)blockIdx.x);
          pg8::EpiRes E{x0, x1, p.out};
          pg8::gemm_phase<pg8::EpiRes, pg8::StaticOrder, true, true>(lds, g, S, E); }
#endif
        if (layer == 0) cg::this_grid().sync();
    }
}

extern "C" void kernel_launch(void* const* d_in, const int* in_sizes, int n_in, void* d_out, int out_size, void* d_ws, size_t ws_size, hipStream_t stream) {
    static int grid_blocks = 0;
    if (grid_blocks == 0) {
        if (n_in != 13 || out_size != MT * DM || ws_size < WS_END) { fprintf(stderr, "kernel_launch: unexpected shapes (n_in %d, out %d, ws %zu < %zu)\n", n_in, out_size, ws_size, (size_t)WS_END); grid_blocks = -1; return; }
        int dev = 0, cus = 0, per_cu = 0;
        hipGetDevice(&dev); hipDeviceGetAttribute(&cus, hipDeviceAttributeMultiprocessorCount, dev);
        hipFuncSetAttribute((const void*)fwd_megakernel, hipFuncAttributeMaxDynamicSharedMemorySize, LDS_BYTES);
        hipOccupancyMaxActiveBlocksPerMultiprocessor(&per_cu, (const void*)fwd_megakernel, NTHREADS, LDS_BYTES);
        if (per_cu < 1) { fprintf(stderr, "kernel_launch: occupancy query says %d blocks/CU\n", per_cu); per_cu = 1; }
        (void)hipGetLastError();
        grid_blocks = cus * 1;
    }
    if (grid_blocks < 0) return;
    hipMemsetAsync((char*)d_ws + WS_CTL, 0, CTL_BYTES, stream);
    Params p{};
    p.x_prompt = (const float*)d_in[0]; p.x_sample = (const float*)d_in[1]; p.ln_g = (const float*)d_in[2]; p.w_in = (const float*)d_in[3]; p.qna = (const float*)d_in[4]; p.kna = (const float*)d_in[5];
    p.sink = (const float*)d_in[6]; p.qnb = (const float*)d_in[7]; p.knb = (const float*)d_in[8]; p.qnc = (const float*)d_in[9]; p.knc = (const float*)d_in[10]; p.rel_bias = (const float*)d_in[11];
    p.w_out = (const float*)d_in[12]; p.out = (float*)d_out; p.ws = (unsigned char*)d_ws;
    void* args[] = {&p};
    hipError_t e = hipLaunchCooperativeKernel((const void*)fwd_megakernel, dim3(grid_blocks), dim3(NTHREADS), args, LDS_BYTES, stream);
    if (e != hipSuccess) fprintf(stderr, "cooperative launch failed: %s (grid %d)\n", hipGetErrorString(e), grid_blocks);
}
```

```cpp
#include <hip/hip_runtime.h>
#include <hip/hip_cooperative_groups.h>
#include <cstdio>
#include <cstdint>
namespace cg = cooperative_groups;

constexpr int DM = 2048, NP = 6656, MP = 8192, MS = 32768, MT = MP + MS;
constexpr int C_QA = 0, C_KA = 768, C_VA = 960, C_GA = 1152, C_QB = 1920, C_KB = 2688, C_VB = 2880, C_GB = 3072, C_QC = 3840, C_KC = 5376, C_VC = 5760, C_GC = 6144;
constexpr float QSCALE = 0.125f * 1.4426950408889634f;
constexpr float LOG2E = 1.4426950408889634f;
constexpr float RMS_EPS = 1e-6f;

namespace pg8 {
#define PG8_LAS __attribute__((address_space(3)))
typedef unsigned short bf16_t;
typedef short bf16x8 __attribute__((ext_vector_type(8)));
typedef float f32x4 __attribute__((ext_vector_type(4)));
typedef unsigned u32x4 __attribute__((ext_vector_type(4)));
constexpr int BM = 256, BK = 64, HALF = 128, HTB = HALF * BK * 2  , STAGE_BYTES = 8 * HTB, NXCD = 8, WGM = 8;

__host__ __device__ __forceinline__ int lds_byte(int r, int c) { const int st = (r >> 4) * 2 + (c >> 5), rr = r & 15, cc = c & 31, ob = rr * 64 + cc * 2; return st * 1024 + (ob ^ (((ob >> 9) & 1) << 5)); }
__host__ __device__ __forceinline__ void stage_rc(int b, int& R, int& C) { const int st = b / 1024, sb = b % 1024, swz = sb ^ (((sb >> 9) & 1) << 5); R = (st >> 1) * 16 + swz / 64; C = (st & 1) * 32 + (swz % 64) / 2; }
__host__ __device__ __forceinline__ int perm32(int rho) { const int n = rho >> 4, i = rho & 15; return 8 * (i >> 2) + 4 * n + (i & 3); }

struct Unit { int pm, pn; };
struct Gemm { const bf16_t* A; const bf16_t* Bt; int M, N, K; };

struct StaticOrder {
    int nM, nN, nwg, G, c;
    __host__ __device__ void init(int M, int N, int G_, int c_) { nM = M / BM; nN = N / BM; nwg = nM * nN; G = G_; c = c_; }
    __host__ __device__ bool next(int i, Unit& u) const {
        const long L = (long)i * G + c; if (L >= nwg) return false;
        int wgid = (int)L; { const int q = nwg / NXCD, r = nwg % NXCD, xcd = wgid % NXCD, off = wgid / NXCD; wgid = (xcd < r ? xcd * (q + 1) : r * (q + 1) + (xcd - r) * q) + off; }
        const int nig = WGM * nN, gid = wgid / nig, fm = gid * WGM, gsz = (nM - fm) < WGM ? (nM - fm) : WGM;
        u.pm = fm + ((wgid % nig) % gsz); u.pn = (wgid % nig) / gsz; return true;
    }
    __device__ __forceinline__ void a_ready(const Unit&) const {}
    __device__ __forceinline__ void done(const Unit&) const {}
};

__device__ __forceinline__ unsigned cvt_pk_bf16(float lo, float hi) { unsigned r; asm volatile("v_cvt_pk_bf16_f32 %0, %1, %2" : "=v"(r) : "v"(lo), "v"(hi)); return r; }
typedef float f32x2e __attribute__((ext_vector_type(2)));
struct EpiProj {
    static constexpr bool PERM = true, AFTER_DRAIN = false;
    bf16_t* P; const float *qna, *kna, *qnb, *knb, *qnc, *knc; const float* rope;
    __device__ __forceinline__ void operator()(const f32x4 (&acc)[2][2][4][2], const Unit& u, int wr, int wc, int fr, int fq) const {
        const int hd = u.pn * 4 + wc;
        int type; const float* w = qna; float qs = 1.f;
        if (hd < 12) { type = 2; w = qna; qs = QSCALE; } else if (hd < 15) { type = 2; w = kna; } else if (hd < 18) { type = 0; } else if (hd < 30) { type = 1; }
        else if (hd < 42) { type = 3; w = qnb; qs = QSCALE; } else if (hd < 45) { type = 3; w = knb; } else if (hd < 48) { type = 0; } else if (hd < 60) { type = 1; }
        else if (hd < 84) { type = 2; w = qnc; qs = QSCALE; } else if (hd < 90) { type = 2; w = knc; } else if (hd < 96) { type = 0; } else { type = 1; }
        const int row0 = u.pm * BM + wr * 64 + fr;
        bf16_t* base = P + (size_t)row0 * NP + hd * 64 + 8 * fq;
        if (type == 0) {
#pragma unroll
            for (int ai = 0; ai < 2; ++ai)
#pragma unroll
                for (int m = 0; m < 4; ++m) { bf16_t* rowp = base + (size_t)(ai * HALF + m * 16) * NP;
#pragma unroll
                    for (int bj = 0; bj < 2; ++bj) { const f32x4 v0 = acc[ai][bj][m][0], v1 = acc[ai][bj][m][1]; u32x4 o;
                        o.x = cvt_pk_bf16(v0[0], v0[1]); o.y = cvt_pk_bf16(v0[2], v0[3]); o.z = cvt_pk_bf16(v1[0], v1[1]); o.w = cvt_pk_bf16(v1[2], v1[3]);
                        *(u32x4*)(rowp + bj * 32) = o; } }
        } else if (type == 1) {
#pragma unroll
            for (int ai = 0; ai < 2; ++ai)
#pragma unroll
                for (int m = 0; m < 4; ++m) { bf16_t* rowp = base + (size_t)(ai * HALF + m * 16) * NP;
#pragma unroll
                    for (int bj = 0; bj < 2; ++bj) { f32x4 v[2] = {acc[ai][bj][m][0], acc[ai][bj][m][1]};
#pragma unroll
                        for (int n = 0; n < 2; ++n)
#pragma unroll
                            for (int e = 0; e < 4; ++e) { const float g = v[n][e]; v[n][e] = g * __builtin_amdgcn_rcpf(1.f + __builtin_amdgcn_exp2f(-g * LOG2E)); }
                        u32x4 o; o.x = cvt_pk_bf16(v[0][0], v[0][1]); o.y = cvt_pk_bf16(v[0][2], v[0][3]); o.z = cvt_pk_bf16(v[1][0], v[1][1]); o.w = cvt_pk_bf16(v[1][2], v[1][3]);
                        *(u32x4*)(rowp + bj * 32) = o; } }
        } else {
            f32x4 wv[2][2];
#pragma unroll
            for (int bj = 0; bj < 2; ++bj)
#pragma unroll
                for (int n = 0; n < 2; ++n) wv[bj][n] = *(const f32x4*)(w + 32 * bj + 8 * fq + 4 * n);
            const float sgn = (fq < 2) ? -1.f : 1.f;
#pragma unroll
            for (int ai = 0; ai < 2; ++ai)
#pragma unroll
                for (int m = 0; m < 4; ++m) { bf16_t* rowp = base + (size_t)(ai * HALF + m * 16) * NP;
                    f32x4 v[2][2]; float ss = 0.f;
#pragma unroll
                    for (int bj = 0; bj < 2; ++bj)
#pragma unroll
                        for (int n = 0; n < 2; ++n) { v[bj][n] = acc[ai][bj][m][n]; const f32x4 x = v[bj][n]; ss += (x[0] * x[0] + x[1] * x[1]) + (x[2] * x[2] + x[3] * x[3]); }
                    ss += __shfl_xor(ss, 16); ss += __shfl_xor(ss, 32);
                    const float rs = __builtin_amdgcn_rsqf(ss * (1.0f / 64.0f) + RMS_EPS);
#pragma unroll
                    for (int bj = 0; bj < 2; ++bj)
#pragma unroll
                        for (int n = 0; n < 2; ++n) v[bj][n] = v[bj][n] * rs * wv[bj][n];
                    if (type == 3) {
                        const int r = row0 + ai * HALF + m * 16, t = r & ((r < MP) ? 2047 : 4095);
#pragma unroll
                        for (int bj = 0; bj < 2; ++bj) { const int pos = bj ? (t & 63) : (t >> 6);
#pragma unroll
                            for (int n = 0; n < 2; ++n) { const float* tp = rope + (size_t)(pos * 16 + 8 * (fq & 1) + 4 * n) * 2;
                                const f32x4 cs0 = *(const f32x4*)tp, cs1 = *(const f32x4*)(tp + 4); const f32x4 x = v[bj][n]; f32x4 pr;
                                pr[0] = __shfl_xor(x[0], 32); pr[1] = __shfl_xor(x[1], 32); pr[2] = __shfl_xor(x[2], 32); pr[3] = __shfl_xor(x[3], 32);
                                f32x4 y; y[0] = x[0] * cs0[0] + sgn * pr[0] * cs0[1]; y[1] = x[1] * cs0[2] + sgn * pr[1] * cs0[3];
                                y[2] = x[2] * cs1[0] + sgn * pr[2] * cs1[1]; y[3] = x[3] * cs1[2] + sgn * pr[3] * cs1[3]; v[bj][n] = y; } }
                    }
#pragma unroll
                    for (int bj = 0; bj < 2; ++bj) { const f32x4 v0 = v[bj][0] * qs, v1 = v[bj][1] * qs; u32x4 o;
                        o.x = cvt_pk_bf16(v0[0], v0[1]); o.y = cvt_pk_bf16(v0[2], v0[3]); o.z = cvt_pk_bf16(v1[0], v1[1]); o.w = cvt_pk_bf16(v1[2], v1[3]);
                        *(u32x4*)(rowp + bj * 32) = o; } }
        }
    }
};
struct EpiRes {
    static constexpr bool PERM = true, AFTER_DRAIN = false;
    const float* x0; const float* x1; float* out;
    __device__ __forceinline__ void operator()(const f32x4 (&acc)[2][2][4][2], const Unit& u, int wr, int wc, int fr, int fq) const {
        const int row0 = u.pm * BM + wr * 64 + fr, col0 = u.pn * BM + wc * 32 + 8 * fq;
        const float* xb = (row0 < MP) ? x0 + (size_t)row0 * DM : x1 + (size_t)(row0 - MP) * DM;
        float* ob = out + (size_t)row0 * DM;
#pragma unroll
        for (int ai = 0; ai < 2; ++ai)
#pragma unroll
            for (int m = 0; m < 4; ++m) { const size_t off = (size_t)(ai * HALF + m * 16) * DM + col0;
#pragma unroll
                for (int bj = 0; bj < 2; ++bj) { const f32x4 a0 = *(const f32x4*)(xb + off + bj * HALF), a1 = *(const f32x4*)(xb + off + bj * HALF + 4);
                    *(f32x4*)(ob + off + bj * HALF) = a0 + acc[ai][bj][m][0]; *(f32x4*)(ob + off + bj * HALF + 4) = a1 + acc[ai][bj][m][1]; } }
    }
};

template <class Epi, class Sched, bool ALIGN_EPI = false, bool SP2 = false>
__device__ __forceinline__ void gemm_phase(PG8_LAS unsigned char* lds, const Gemm g, const Sched& S, const Epi& E) {
    int tid_l = threadIdx.x; asm volatile("" : "+v"(tid_l));
    const int tid = tid_l, wid = __builtin_amdgcn_readfirstlane(tid >> 6), lane = tid & 63, wr = wid >> 2, wc = wid & 3, fr = lane & 15, fq = lane >> 4;
    const int K = g.K, nt = K / BK;
    unsigned voffA[2], voffB[2];
#pragma unroll
    for (int i = 0; i < 2; ++i) { int R, C; stage_rc(tid * 16 + i * 8192, R, C); const int Rb = Epi::PERM ? ((R & ~31) + perm32(R & 31)) : R;
        voffA[i] = (unsigned)(R * K + C) * 2u; voffB[i] = (unsigned)(Rb * K + C) * 2u; }
    const size_t kstep = (size_t)(BK * 2);
    const size_t hstep = (size_t)HALF * K * 2;
    const size_t tstep = 2 * hstep;
    const unsigned ldsw = (unsigned)wid * 1024u;
    const int aoff = lds_byte(wr * 64 + fr, fq * 8), boff = lds_byte(wc * 32 + fr, fq * 8);
#define PG8_SA(b, h) (((b) * 2 + (h)) * HTB)
#define PG8_SB(b, h) ((4 + (b) * 2 + (h)) * HTB)
#define PG8_STAGE(bufoff, gbase, voff) do { _Pragma("unroll") for (int _i = 0; _i < 2; ++_i) \
        __builtin_amdgcn_global_load_lds((const unsigned*)((const char*)(gbase) + (voff)[_i]), (PG8_LAS unsigned*)(lds + (bufoff) + ldsw + _i * 8192), 16, 0, 0); } while (0)
#define PG8_LDA(dst, b, h) do { _Pragma("unroll") for (int m = 0; m < 4; ++m) _Pragma("unroll") for (int k = 0; k < 2; ++k) dst[m][k] = *(const PG8_LAS bf16x8*)(lds + PG8_SA(b, h) + aoff + m * 2048 + k * 1024); } while (0)
#define PG8_LDB(dst, b, h) do { _Pragma("unroll") for (int n = 0; n < 2; ++n) _Pragma("unroll") for (int k = 0; k < 2; ++k) dst[n][k] = *(const PG8_LAS bf16x8*)(lds + PG8_SB(b, h) + boff + n * 2048 + k * 1024); } while (0)
#define PG8_MMA(ai, bj, At, Bt) do { __builtin_amdgcn_s_setprio(1); _Pragma("unroll") for (int m = 0; m < 4; ++m) _Pragma("unroll") for (int n = 0; n < 2; ++n) _Pragma("unroll") for (int k = 0; k < 2; ++k) \
        acc[ai][bj][m][n] = __builtin_amdgcn_mfma_f32_16x16x32_bf16(Bt[n][k], At[m][k], acc[ai][bj][m][n], 0, 0, 0); __builtin_amdgcn_s_setprio(0); } while (0)
#define PG8_WAIT_V(n) asm volatile("s_waitcnt vmcnt(" #n ")" ::: "memory")
#define PG8_WAIT_L(n) asm volatile("s_waitcnt lgkmcnt(" #n ")" ::: "memory")
#define PG8_BAR __builtin_amdgcn_s_barrier()
#define PG8_SCHED __builtin_amdgcn_sched_barrier(0)
    Unit cur, nxt; int ui = 0;
    if (!S.next(0, cur)) return;
    f32x4 acc[2][2][4][2];
#pragma unroll
    for (int a = 0; a < 2; ++a)
#pragma unroll
        for (int b = 0; b < 2; ++b)
#pragma unroll
            for (int m = 0; m < 4; ++m)
#pragma unroll
                for (int n = 0; n < 2; ++n) acc[a][b][m][n] = (f32x4){0.f, 0.f, 0.f, 0.f};
    bf16x8 At[4][2], B0[2][2], B1[2][2];
    const char* cA = (const char*)g.A + (size_t)cur.pm * tstep; const char* cB = (const char*)g.Bt + (size_t)cur.pn * tstep;
    S.a_ready(cur);
    if constexpr (SP2) {
        PG8_STAGE(PG8_SB(0, 0), cB, voffB); PG8_STAGE(PG8_SB(0, 1), cB + hstep, voffB); PG8_STAGE(PG8_SA(0, 0), cA, voffA); PG8_STAGE(PG8_SA(0, 1), cA + hstep, voffA);
        if (wr == 1) PG8_BAR;
        PG8_WAIT_V(2); PG8_BAR;
        PG8_STAGE(PG8_SB(1, 0), cB + kstep, voffB); PG8_STAGE(PG8_SA(1, 0), cA + kstep, voffA); PG8_STAGE(PG8_SB(1, 1), cB + hstep + kstep, voffB);
        PG8_WAIT_V(6); PG8_BAR;
    } else {
        PG8_STAGE(PG8_SB(0, 0), cB, voffB); PG8_STAGE(PG8_SA(0, 0), cA, voffA); PG8_STAGE(PG8_SB(0, 1), cB + hstep, voffB); PG8_STAGE(PG8_SA(0, 1), cA + hstep, voffA);
        if (wr == 1) PG8_BAR;
        PG8_WAIT_V(4); PG8_BAR;
        PG8_STAGE(PG8_SB(1, 0), cB + kstep, voffB); PG8_STAGE(PG8_SA(1, 0), cA + kstep, voffA); PG8_STAGE(PG8_SB(1, 1), cB + hstep + kstep, voffB);
        PG8_WAIT_V(6); PG8_BAR;
    }
    for (;;) {
        const bool has_next = S.next(ui + 1, nxt);
        const char* nA = has_next ? (const char*)g.A + (size_t)nxt.pm * tstep : cA; const char* nB = has_next ? (const char*)g.Bt + (size_t)nxt.pn * tstep : cB;
        for (int t = 0; t < nt; t += 2) {
            const bool last = (t == nt - 2);
            const char* a1 = cA + (size_t)(t + 1) * kstep;
            const char* a2 = last ? nA : cA + (size_t)(t + 2) * kstep; const char* b2 = last ? nB : cB + (size_t)(t + 2) * kstep;
            const char* a3 = a2 + kstep; const char* b3 = b2 + kstep;
            if (last && has_next) S.a_ready(nxt);
            if constexpr (SP2) {
            PG8_LDB(B0, 0, 0); PG8_LDB(B1, 0, 1); PG8_SCHED; PG8_LDA(At, 0, 0); PG8_STAGE(PG8_SA(1, 1), a1 + hstep, voffA);
            PG8_WAIT_V(8); PG8_WAIT_L(0); PG8_BAR; PG8_MMA(0, 0, At, B0); PG8_MMA(0, 1, At, B1); PG8_BAR; PG8_SCHED;
            PG8_LDA(At, 0, 1); PG8_STAGE(PG8_SB(0, 0), b2, voffB); PG8_STAGE(PG8_SB(0, 1), b2 + hstep, voffB); PG8_STAGE(PG8_SA(0, 0), a2, voffA);
            PG8_WAIT_V(8); PG8_WAIT_L(0); PG8_BAR; PG8_MMA(1, 0, At, B0); PG8_MMA(1, 1, At, B1); PG8_BAR; PG8_SCHED;
            PG8_LDB(B0, 1, 0); PG8_LDB(B1, 1, 1); PG8_SCHED; PG8_LDA(At, 1, 0); PG8_STAGE(PG8_SA(0, 1), a2 + hstep, voffA);
            PG8_WAIT_V(8); PG8_WAIT_L(0); PG8_BAR; PG8_MMA(0, 0, At, B0); PG8_MMA(0, 1, At, B1); PG8_BAR; PG8_SCHED;
            PG8_LDA(At, 1, 1); PG8_STAGE(PG8_SB(1, 0), b3, voffB); PG8_STAGE(PG8_SB(1, 1), b3 + hstep, voffB); PG8_STAGE(PG8_SA(1, 0), a3, voffA);
            PG8_WAIT_V(8); PG8_WAIT_L(0); PG8_BAR; PG8_MMA(1, 0, At, B0); PG8_MMA(1, 1, At, B1); PG8_BAR; PG8_SCHED;
            } else {
            PG8_LDB(B0, 0, 0); PG8_SCHED; PG8_LDA(At, 0, 0); PG8_STAGE(PG8_SA(1, 1), a1 + hstep, voffA);
            PG8_WAIT_L(8); PG8_BAR; PG8_WAIT_L(0); PG8_MMA(0, 0, At, B0); PG8_BAR; PG8_SCHED;
            PG8_LDB(B1, 0, 1); PG8_STAGE(PG8_SB(0, 0), b2, voffB);
            PG8_BAR; PG8_WAIT_L(0); PG8_MMA(0, 1, At, B1); PG8_BAR;
            PG8_LDA(At, 0, 1); PG8_STAGE(PG8_SA(0, 0), a2, voffA);
            PG8_BAR; PG8_WAIT_L(0); PG8_MMA(1, 0, At, B0); PG8_BAR; PG8_SCHED;
            PG8_STAGE(PG8_SB(0, 1), b2 + hstep, voffB);
            PG8_WAIT_V(6); PG8_BAR; PG8_MMA(1, 1, At, B1); PG8_BAR;
            PG8_LDB(B0, 1, 0); PG8_SCHED; PG8_LDA(At, 1, 0); PG8_STAGE(PG8_SA(0, 1), a2 + hstep, voffA);
            PG8_WAIT_L(8); PG8_BAR; PG8_WAIT_L(0); PG8_MMA(0, 0, At, B0); PG8_BAR; PG8_SCHED;
            PG8_LDB(B1, 1, 1); PG8_STAGE(PG8_SB(1, 0), b3, voffB);
            PG8_BAR; PG8_WAIT_L(0); PG8_MMA(0, 1, At, B1); PG8_BAR;
            PG8_LDA(At, 1, 1); PG8_STAGE(PG8_SA(1, 0), a3, voffA);
            PG8_BAR; PG8_WAIT_L(0); PG8_MMA(1, 0, At, B0); PG8_BAR; PG8_SCHED;
            PG8_STAGE(PG8_SB(1, 1), b3 + hstep, voffB);
            PG8_WAIT_V(6); PG8_BAR; PG8_MMA(1, 1, At, B1); PG8_BAR;
            }
        }
        if constexpr (ALIGN_EPI) { if (wr == 0) PG8_BAR; }
        if constexpr (!Epi::AFTER_DRAIN) { E(acc, cur, wr, wc, fr, fq); S.done(cur); }
        if (!has_next) break;
#pragma unroll
        for (int a = 0; a < 2; ++a)
#pragma unroll
            for (int b = 0; b < 2; ++b)
#pragma unroll
                for (int m = 0; m < 4; ++m)
#pragma unroll
                    for (int n = 0; n < 2; ++n) acc[a][b][m][n] = (f32x4){0.f, 0.f, 0.f, 0.f};
        cur = nxt; cA = nA; cB = nB; ++ui;
        if constexpr (ALIGN_EPI) { if (wr == 1) PG8_BAR; }
    }
    PG8_WAIT_V(0);
    if constexpr (!ALIGN_EPI) { if (wr == 0) PG8_BAR; }
    PG8_BAR;
    if constexpr (Epi::AFTER_DRAIN) { E.fused(acc, cur, wr, wc, fr, fq, lds, wid, lane); S.done(cur); }
#undef PG8_SA
#undef PG8_SB
#undef PG8_STAGE
#undef PG8_LDA
#undef PG8_LDB
#undef PG8_MMA
#undef PG8_WAIT_V
#undef PG8_WAIT_L
#undef PG8_BAR
#undef PG8_SCHED
}
}

#define LAS __attribute__((address_space(3)))
typedef unsigned short bf16_t;
typedef short bf16x8 __attribute__((ext_vector_type(8)));
typedef short s16x4 __attribute__((ext_vector_type(4)));
typedef float f32x4 __attribute__((ext_vector_type(4)));
typedef float f32x16 __attribute__((ext_vector_type(16)));
typedef unsigned u32x4 __attribute__((ext_vector_type(4)));
typedef unsigned u32x2 __attribute__((ext_vector_type(2)));
constexpr int NWAVES = 8, NTHREADS = 512;
constexpr int LDS_BYTES = 139264;
__device__ __forceinline__ unsigned pk_bf16(float lo, float hi) { unsigned r; asm volatile("v_cvt_pk_bf16_f32 %0, %1, %2" : "=v"(r) : "v"(lo), "v"(hi)); return r; }
__device__ __forceinline__ float bf_lo(unsigned w) { return __uint_as_float(w << 16); }
__device__ __forceinline__ float bf_hi(unsigned w) { return __uint_as_float(w & 0xffff0000u); }

constexpr size_t WS_CTL = 0, CTL_BYTES = 32768;
constexpr int CW_BAR = 4096, XBAR_LDS = 131072 + 512;
constexpr size_t WS_TAB = 65536;
constexpr int TABA_W = 513, TABC_W = 385, TABA_N = 12 * TABA_W, TABC_N = 24 * TABC_W, ROPE_N = 64 * 16 * 2;
constexpr size_t WS_WIN = 1u << 20;
constexpr size_t WS_WOUT = WS_WIN + (size_t)2 * NP * DM * 2;
constexpr size_t WS_H = WS_WOUT + (size_t)2 * DM * DM * 2;
constexpr size_t WS_P = WS_H + (size_t)MT * DM * 2;
constexpr size_t WS_CS = WS_P + (size_t)MT * NP * 2;
constexpr size_t WS_LSE = WS_CS + (size_t)3 * MT * 512 * 2;
constexpr size_t WS_END = WS_LSE + (size_t)3 * MT * 8 * 4;

__constant__ float INVF[16] = {1.0f, 0.5623413251903491f, 0.31622776601683794f, 0.1778279410038923f, 0.1f, 0.05623413251903491f, 0.03162277660168379f, 0.01778279410038923f,
                               0.01f, 0.005623413251903491f, 0.0031622776601683794f, 0.0017782794100389228f, 0.001f, 0.0005623413251903491f, 0.00031622776601683794f, 0.00017782794100389227f};

struct Params {
    const float* x_prompt; const float* x_sample; const float* ln_g; const float* w_in; const float* qna; const float* kna; const float* sink; const float* qnb; const float* knb;
    const float* qnc; const float* knc; const float* rel_bias; const float* w_out; float* out; unsigned char* ws;
};

__device__ __forceinline__ int t5_bucket(int rel) {
    const int n = rel < 0 ? -rel : rel;
    const int large = 8 + (n >= 15) + (n >= 27) + (n >= 50) + (n >= 91) + (n >= 166) + (n >= 305) + (n >= 559);
    return (rel > 0 ? 16 : 0) + (n < 8 ? n : large);
}
template <bool PERMUTE>
__device__ __forceinline__ void transpose_item(const float* W, int K, int N, bf16_t* WT, LAS float* scr, int item, int lane) {
    const int nblk = N / 32, kb = item / nblk, nb = item % nblk, k0 = 64 * kb, n0 = 32 * nb;
    float wv[32];
#pragma unroll
    for (int i = 0; i < 32; ++i) wv[i] = W[(size_t)(k0 + 2 * i + (lane >> 5)) * N + n0 + (lane & 31)];
#pragma unroll
    for (int i = 0; i < 32; ++i) scr[(2 * i + (lane >> 5)) * 33 + (lane & 31)] = wv[i];
    asm volatile("s_waitcnt lgkmcnt(0)" ::: "memory");
    const int c = lane & 7;
    const int r0 = PERMUTE ? (256 * (n0 >> 8) + 128 * ((n0 >> 5) & 1) + 32 * ((n0 >> 6) & 3)) : n0;
#pragma unroll
    for (int j = 0; j < 4; ++j) { const int n = (lane >> 3) + 8 * j; const LAS float* s = scr + (8 * c) * 33 + n;
        u32x4 o; o.x = pk_bf16(s[0 * 33], s[1 * 33]); o.y = pk_bf16(s[2 * 33], s[3 * 33]); o.z = pk_bf16(s[4 * 33], s[5 * 33]); o.w = pk_bf16(s[6 * 33], s[7 * 33]);
        *(u32x4*)(WT + (size_t)(r0 + n) * K + k0 + 8 * c) = o; }
    asm volatile("s_waitcnt lgkmcnt(0)" ::: "memory");
}
__device__ __forceinline__ void prologue_phase(const Params& p, LAS unsigned char* lds, int tid, int wave, int lane) {
    LAS float* scr = (LAS float*)(lds + wave * 16384);
    const int gw = blockIdx.x * NWAVES + wave, NGW = gridDim.x * NWAVES;
    constexpr int I_IN = (DM / 64) * (NP / 32), I_OUT = (DM / 64) * (DM / 32);
    bf16_t* win = (bf16_t*)(p.ws + WS_WIN); bf16_t* wout = (bf16_t*)(p.ws + WS_WOUT);
    for (int it = gw; it < 2 * (I_IN + I_OUT); it += NGW) {
        int r = it;
        if (r < 2 * I_IN) { const int l = r / I_IN; r -= l * I_IN; transpose_item<true>(p.w_in + (size_t)l * DM * NP, DM, NP, win + (size_t)l * NP * DM, scr, r, lane); }
        else { r -= 2 * I_IN; const int l = r / I_OUT; r -= l * I_OUT; transpose_item<false>(p.w_out + (size_t)l * DM * DM, DM, DM, wout + (size_t)l * DM * DM, scr, r, lane); }
    }
    float* tab = (float*)(p.ws + WS_TAB);
    for (int i = blockIdx.x * NTHREADS + tid; i < TABA_N + TABC_N + ROPE_N / 2; i += gridDim.x * NTHREADS) {
        if (i < TABA_N) { const int h = i / TABA_W, rel = i % TABA_W - 256; tab[i] = (rel >= -128 && rel <= 128) ? p.rel_bias[t5_bucket(rel) * 36 + h] * LOG2E : -INFINITY; }
        else if (i < TABA_N + TABC_N) { const int j = i - TABA_N, gh = j / TABC_W, rel = j % TABC_W - 192, g = gh >> 3; const int dil = (g == 0) ? 1 : (g == 1 ? 4 : 16);
            tab[i] = (rel >= -64 && rel <= 64) ? p.rel_bias[t5_bucket(rel * dil) * 36 + 12 + gh] * LOG2E : -INFINITY; }
        else { const int j = i - TABA_N - TABC_N, pos = j >> 4, f = j & 15; const float ang = (float)pos * INVF[f];
            tab[TABA_N + TABC_N + 2 * j] = cosf(ang); tab[TABA_N + TABC_N + 2 * j + 1] = sinf(ang); }
    }
}
__device__ __forceinline__ void norm_phase(const float* x0, const float* x1, const float* g, bf16_t* H, int wave, int lane) {
    const int gw = blockIdx.x * NWAVES + wave, NGW = gridDim.x * NWAVES;
    f32x4 nx[8];
    { const f32x4* xr = (const f32x4*)((gw < MP) ? x0 + (size_t)gw * DM : x1 + (size_t)(gw - MP) * DM) + lane;
#pragma unroll
      for (int j = 0; j < 8; ++j) nx[j] = xr[64 * j]; }
    for (int row = gw; row < MT; row += NGW) {
        f32x4 v[8]; float s = 0.f;
#pragma unroll
        for (int j = 0; j < 8; ++j) v[j] = nx[j];
        const int nr = row + NGW;
        if (nr < MT) { const f32x4* xr = (const f32x4*)((nr < MP) ? x0 + (size_t)nr * DM : x1 + (size_t)(nr - MP) * DM) + lane;
#pragma unroll
            for (int j = 0; j < 8; ++j) nx[j] = xr[64 * j]; }
#pragma unroll
        for (int j = 0; j < 8; ++j) s += (v[j][0] * v[j][0] + v[j][1] * v[j][1]) + (v[j][2] * v[j][2] + v[j][3] * v[j][3]);
#pragma unroll
        for (int o = 1; o < 64; o <<= 1) s += __shfl_xor(s, o);
        const float rs = 1.0f / sqrtf(s * (1.0f / DM) + RMS_EPS);
        u32x2* o8 = (u32x2*)(H + (size_t)row * DM) + lane;
#pragma unroll
        for (int j = 0; j < 8; ++j) { const f32x4 gv = ((const f32x4*)g)[lane + 64 * j]; u32x2 o;
            o.x = pk_bf16(v[j][0] * rs * gv[0], v[j][1] * rs * gv[1]); o.y = pk_bf16(v[j][2] * rs * gv[2], v[j][3] * rs * gv[3]); o8[64 * j] = o; }
    }
}

#define XB_TMO      128
#define XB_XCNT(j)  (256  + 64 * (j))
#define XB_XSUB(j)  (1280 + 64 * (j))
#define XB_XGEN(j)  (2304 + 64 * (j))
#define XB_TOP      3328
#define XB_TOPGEN   3392
#define XCD_BAR_WORDS 3456
#define XB_SPIN_CAP (1u << 18)

__device__ __forceinline__ unsigned xb_ld(unsigned* p)              { return __hip_atomic_load(p, __ATOMIC_RELAXED, __HIP_MEMORY_SCOPE_AGENT); }
__device__ __forceinline__ unsigned xb_add(unsigned* p, unsigned v) { return __hip_atomic_fetch_add(p, v, __ATOMIC_RELAXED, __HIP_MEMORY_SCOPE_AGENT); }
__device__ __forceinline__ unsigned xb_xcc_id() { return (unsigned)__builtin_amdgcn_s_getreg((3 << 11) | 20) & 0xFu; }
#define XB_SPIN(cond, bar) do { unsigned _sp = 0; while (cond) { __builtin_amdgcn_s_sleep(1); \
    if ((++_sp & 255u) == 0u) { if (xb_ld(&(bar)[XB_TMO])) break; if (_sp > XB_SPIN_CAP) { atomicAdd(&(bar)[XB_TMO], 1u); break; } } } } while (0)

struct XcdBarrier {
    unsigned* bar; unsigned x;
    volatile LAS unsigned* st;
};

__device__ __forceinline__ XcdBarrier xcd_barrier_post(unsigned* bar, volatile LAS unsigned* st) {
    XcdBarrier b; b.bar = bar; b.x = xb_xcc_id(); b.st = st;
    if (threadIdx.x == 0) (void)xb_add(&bar[XB_XCNT(b.x)], 1u);
    return b;
}
__device__ __forceinline__ void xcd_barrier_complete(unsigned* bar, unsigned x, unsigned& nloc, unsigned& nx) {
    const unsigned G = gridDim.x * gridDim.y * gridDim.z;
    unsigned sum, cnt, mine, sp = 0u;
    for (;;) {
        sum = 0u; cnt = 0u; mine = 0u;
#pragma unroll
        for (unsigned j = 0; j < 16; ++j) { const unsigned c = xb_ld(&bar[XB_XCNT(j)]); sum += c; cnt += (c > 0u) ? 1u : 0u; mine = (j == x) ? c : mine; }
        if (sum == G) break;
        __builtin_amdgcn_s_sleep(1);
        if ((++sp & 255u) == 0u) { if (xb_ld(&bar[XB_TMO])) break; if (sp > XB_SPIN_CAP) { atomicAdd(&bar[XB_TMO], 1u); break; } }
    }
    nloc = mine > 0u ? mine : 1u; nx = cnt > 0u ? cnt : 1u;
}

__device__ __forceinline__ void xcd_barrier(const XcdBarrier& b) {
    asm volatile("s_waitcnt vmcnt(0)" ::: "memory");
    __syncthreads();
    if (threadIdx.x == 0) {
        unsigned* bar = b.bar;
        __builtin_amdgcn_s_waitcnt(0);
        unsigned nloc = b.st[0], nx = b.st[1];
        if (nloc == 0u) { xcd_barrier_complete(bar, b.x, nloc, nx); b.st[0] = nloc; b.st[1] = nx; }
        const unsigned old = xb_add(&bar[XB_XSUB(b.x)], 1u);
        const unsigned gen = old / nloc;
        if (old + 1u == (gen + 1u) * nloc) {
            __builtin_amdgcn_fence(__ATOMIC_RELEASE, "agent");
            asm volatile("s_waitcnt vmcnt(0)" ::: "memory");
            const unsigned og = xb_add(&bar[XB_TOP], 1u);
            const unsigned tg = og / nx;
            if (og + 1u == (tg + 1u) * nx) xb_add(&bar[XB_TOPGEN], 1u);
            else XB_SPIN(xb_ld(&bar[XB_TOPGEN]) == tg, bar);
            __builtin_amdgcn_fence(__ATOMIC_ACQUIRE, "agent");
            xb_add(&bar[XB_XGEN(b.x)], 1u);
            asm volatile("s_waitcnt vmcnt(0)" ::: "memory");
        } else {
            XB_SPIN(xb_ld(&bar[XB_XGEN(b.x)]) == gen, bar);
            __builtin_amdgcn_fence(__ATOMIC_ACQUIRE, "agent");
            asm volatile("s_waitcnt vmcnt(0)" ::: "memory");
        }
    }
    __syncthreads();
}
namespace att {
constexpr int KP = 144, VP = 192, KBUF = 64 * KP, VBUF = 64 * VP, BUFB = KBUF + VBUF;
constexpr int L_TAB = 2 * BUFB, L_SLOT = L_TAB + (TABA_N + TABC_N) * 4;
static_assert(L_SLOT + 64 <= LDS_BYTES, "attention LDS map");
constexpr int N_BS = 768, N_BP = 192, N_A = 960, N_C = 1920, N_UNITS = N_BS + N_BP + N_A + N_C;
constexpr float THR = 5.0f;
typedef short v4i16_t __attribute__((ext_vector_type(4)));
__device__ __forceinline__ s16x4 vtr(const LAS unsigned char* p) { return __builtin_bit_cast(s16x4, __builtin_amdgcn_ds_read_tr16_b64_v4i16((LAS v4i16_t*)p)); }
#define MFMA32(a, b, c) __builtin_amdgcn_mfma_f32_32x32x16_bf16((a), (b), (c), 0, 0, 0)

struct UnitP { int rowbase, dil, rho, i0, t_lo, t_hi, qcol, kcol, vcol, gcol, ocol, tabidx, g, kvi; };

__device__ __forceinline__ void softmax_step(f32x16& p0, f32x16& p1, float& m, float& l, f32x16& o0, f32x16& o1) {
    float a = fmaxf(fmaxf(p0[0], p0[1]), p1[0]), b = fmaxf(fmaxf(p0[2], p0[3]), p1[1]); a = fmaxf(fmaxf(a, p1[2]), p1[3]);
#pragma unroll
    for (int r = 4; r < 16; r += 4) { a = fmaxf(fmaxf(a, p0[r]), p0[r + 1]); b = fmaxf(fmaxf(b, p0[r + 2]), p0[r + 3]); a = fmaxf(fmaxf(a, p1[r]), p1[r + 1]); b = fmaxf(fmaxf(b, p1[r + 2]), p1[r + 3]); }
    float rm = fmaxf(a, b);
    { auto rr = __builtin_amdgcn_permlane32_swap(__float_as_uint(rm), __float_as_uint(rm), false, false); rm = fmaxf(__uint_as_float(rr[0]), __uint_as_float(rr[1])); }
    if (__any(rm > m + THR)) { const float mn = fmaxf(m, rm), al = __builtin_amdgcn_exp2f(m - mn); m = mn; l *= al; o0 = o0 * al; o1 = o1 * al; }
    float ls0 = 0.f, ls1 = 0.f;
#pragma unroll
    for (int r = 0; r < 16; ++r) { p0[r] = __builtin_amdgcn_exp2f(p0[r] - m); p1[r] = __builtin_amdgcn_exp2f(p1[r] - m); ls0 += p0[r]; ls1 += p1[r]; }
    l += ls0 + ls1;
}
__device__ __forceinline__ bf16x8 pack8(const f32x16& x, int s) {
    u32x4 w; w.x = pk_bf16(x[8 * s], x[8 * s + 1]); w.y = pk_bf16(x[8 * s + 2], x[8 * s + 3]); w.z = pk_bf16(x[8 * s + 4], x[8 * s + 5]); w.w = pk_bf16(x[8 * s + 6], x[8 * s + 7]);
    return __builtin_bit_cast(bf16x8, w);
}
template <int MODE>
__device__ __forceinline__ void store_block(const Params& p, const UnitP& u, const f32x16& o0, const f32x16& o1, float m, float l, float m_sink, size_t qrow, int hq, int hi) {
    const bf16_t* __restrict__ P = (const bf16_t*)(p.ws + WS_P);
    float lt; { auto rr = __builtin_amdgcn_permlane32_swap(__float_as_uint(l), __float_as_uint(l), false, false); lt = __uint_as_float(rr[0]) + __uint_as_float(rr[1]); }
    if (MODE == 0) lt += __builtin_amdgcn_exp2f(m_sink - m);
    const float inv = __builtin_amdgcn_rcpf(lt);
    if (MODE != 2) {
        bf16_t* mix = (bf16_t*)(p.ws + WS_H) + qrow * DM + u.ocol + hq * 64 + 4 * hi;
        const bf16_t* gp = P + qrow * NP + u.gcol + hq * 64 + 4 * hi;
#pragma unroll
        for (int g = 0; g < 4; ++g) {
            const u32x2 g0 = *(const u32x2*)(gp + 8 * g), g1 = *(const u32x2*)(gp + 32 + 8 * g); u32x2 w0, w1;
            w0.x = pk_bf16(o0[4 * g] * inv * bf_lo(g0.x), o0[4 * g + 1] * inv * bf_hi(g0.x)); w0.y = pk_bf16(o0[4 * g + 2] * inv * bf_lo(g0.y), o0[4 * g + 3] * inv * bf_hi(g0.y));
            w1.x = pk_bf16(o1[4 * g] * inv * bf_lo(g1.x), o1[4 * g + 1] * inv * bf_hi(g1.x)); w1.y = pk_bf16(o1[4 * g + 2] * inv * bf_lo(g1.y), o1[4 * g + 3] * inv * bf_hi(g1.y));
            *(u32x2*)(mix + 8 * g) = w0; *(u32x2*)(mix + 32 + 8 * g) = w1;
        }
    } else {
        bf16_t* cs = (bf16_t*)(p.ws + WS_CS) + ((size_t)u.g * MT + qrow) * 512 + (u.kvi * 4 + hq) * 64 + 4 * hi;
#pragma unroll
        for (int g = 0; g < 4; ++g) { u32x2 w0, w1;
            w0.x = pk_bf16(o0[4 * g] * inv, o0[4 * g + 1] * inv); w0.y = pk_bf16(o0[4 * g + 2] * inv, o0[4 * g + 3] * inv);
            w1.x = pk_bf16(o1[4 * g] * inv, o1[4 * g + 1] * inv); w1.y = pk_bf16(o1[4 * g + 2] * inv, o1[4 * g + 3] * inv);
            *(u32x2*)(cs + 8 * g) = w0; *(u32x2*)(cs + 32 + 8 * g) = w1; }
        if (hi == 0) ((float*)(p.ws + WS_LSE))[((size_t)u.g * MT + qrow) * 8 + u.kvi * 4 + hq] = m + __builtin_amdgcn_logf(lt);
    }
}
template <int MODE, bool SEQ>
__device__ __forceinline__ void tile_loop(const UnitP& u, const bf16_t* kg, const bf16_t* vg, size_t tstep, u32x4 kreg, u32x4 vreg, LAS unsigned char* kst, LAS unsigned char* vst,
                                          const LAS unsigned char* krd, const LAS unsigned char* vrd, const LAS float* btab, int iqa, int hi, int wt_lo, int wt_hi,
                                          const bf16x8 (&qa)[4], const bf16x8 (&qb)[4], float& ma, float& la, float& mb, float& lb, f32x16& oa0, f32x16& oa1, f32x16& ob0, f32x16& ob1) {
    for (int t = u.t_lo; t <= u.t_hi; ++t) {
        const int boff = ((t - u.t_lo) & 1) * BUFB;
        __syncthreads();
        if (t < u.t_hi) { kreg = *(const u32x4*)(kg + (size_t)(t + 1) * tstep); vreg = *(const u32x4*)(vg + (size_t)(t + 1) * tstep); }
        if (MODE == 1 || (t >= wt_lo && t <= wt_hi)) {
          const LAS float* bt = btab + (64 * t - iqa + 4 * hi);
          if (!SEQ) {
            f32x16 pa0 = {}, pa1 = {}, pb0 = {}, pb1 = {};
#pragma unroll
            for (int ds = 0; ds < 4; ++ds) {
                const bf16x8 k0 = *(const LAS bf16x8*)(krd + boff + ds * 32), k1 = *(const LAS bf16x8*)(krd + boff + 32 * KP + ds * 32);
                pa0 = MFMA32(k0, qa[ds], pa0); pa1 = MFMA32(k1, qa[ds], pa1); pb0 = MFMA32(k0, qb[ds], pb0); pb1 = MFMA32(k1, qb[ds], pb1);
            }
            __builtin_amdgcn_sched_barrier(0);
            if (MODE != 1) {
#pragma unroll
                for (int r = 0; r < 16; ++r) { const int o = (r & 3) + 8 * (r >> 2);
                    pa0[r] += bt[o]; pa1[r] += bt[o + 32]; pb0[r] += bt[o - 32]; pb1[r] += bt[o]; }
            }
            softmax_step(pa0, pa1, ma, la, oa0, oa1);
            softmax_step(pb0, pb1, mb, lb, ob0, ob1);
            __builtin_amdgcn_sched_barrier(0);
#pragma unroll
            for (int s = 0; s < 4; ++s) {
                const bf16x8 xa = (s < 2) ? pack8(pa0, s & 1) : pack8(pa1, s & 1), xb = (s < 2) ? pack8(pb0, s & 1) : pack8(pb1, s & 1);
                const LAS unsigned char* vb = vrd + boff + s * 16 * VP;
                const s16x4 a0 = vtr(vb), a1 = vtr(vb + 8 * VP), b0 = vtr(vb + 64), b1 = vtr(vb + 8 * VP + 64);
                const bf16x8 vf0 = __builtin_shufflevector(a0, a1, 0, 1, 2, 3, 4, 5, 6, 7), vf1 = __builtin_shufflevector(b0, b1, 0, 1, 2, 3, 4, 5, 6, 7);
                oa0 = MFMA32(vf0, xa, oa0); oa1 = MFMA32(vf1, xa, oa1); ob0 = MFMA32(vf0, xb, ob0); ob1 = MFMA32(vf1, xb, ob1);
                if (s == 1) __builtin_amdgcn_sched_barrier(0);
            }
          } else {
#define ATT_ONE_BLOCK(QF, M_, L_, O0, O1, BOFS) do { \
            f32x16 p0 = {}, p1 = {}; \
            _Pragma("unroll") for (int ds = 0; ds < 4; ++ds) { \
                const bf16x8 k0 = *(const LAS bf16x8*)(krd + boff + ds * 32), k1 = *(const LAS bf16x8*)(krd + boff + 32 * KP + ds * 32); \
                p0 = MFMA32(k0, QF[ds], p0); p1 = MFMA32(k1, QF[ds], p1); } \
            __builtin_amdgcn_sched_barrier(0); \
            if (MODE != 1) { _Pragma("unroll") for (int r = 0; r < 16; ++r) { const int o = (r & 3) + 8 * (r >> 2); p0[r] += bt[o + (BOFS)]; p1[r] += bt[o + 32 + (BOFS)]; } } \
            softmax_step(p0, p1, M_, L_, O0, O1); \
            __builtin_amdgcn_sched_barrier(0); \
            _Pragma("unroll") for (int s = 0; s < 4; ++s) { \
                const bf16x8 xs = (s < 2) ? pack8(p0, s & 1) : pack8(p1, s & 1); \
                const LAS unsigned char* vb = vrd + boff + s * 16 * VP; \
                const s16x4 a0 = vtr(vb), a1 = vtr(vb + 8 * VP), b0 = vtr(vb + 64), b1 = vtr(vb + 8 * VP + 64); \
                const bf16x8 vf0 = __builtin_shufflevector(a0, a1, 0, 1, 2, 3, 4, 5, 6, 7), vf1 = __builtin_shufflevector(b0, b1, 0, 1, 2, 3, 4, 5, 6, 7); \
                O0 = MFMA32(vf0, xs, O0); O1 = MFMA32(vf1, xs, O1); } \
            __builtin_amdgcn_sched_barrier(0); } while (0)
            ATT_ONE_BLOCK(qa, ma, la, oa0, oa1, 0);
            ATT_ONE_BLOCK(qb, mb, lb, ob0, ob1, -32);
#undef ATT_ONE_BLOCK
          }
        }
        if (t < u.t_hi) { *(LAS u32x4*)(kst + (BUFB - boff)) = kreg; *(LAS u32x4*)(vst + (BUFB - boff)) = vreg; }
    }
}
template <int MODE>
__device__ __forceinline__ void unit(LAS unsigned char* lds, const Params& p, const UnitP& u, int tid, int wave, int lane) {
    const bf16_t* __restrict__ P = (const bf16_t*)(p.ws + WS_P);
    const int r32 = lane & 31, hi = lane >> 5, hq = wave >> 1, sub = wave & 1;
    const int iqa = u.i0 + 64 * sub + r32;
    const size_t qrow_a = (size_t)(u.rowbase + u.rho + u.dil * iqa), qrow_b = qrow_a + (size_t)(32 * u.dil);
    constexpr int W = (MODE == 0) ? 128 : 64, TW = (MODE == 0) ? TABA_W : TABC_W, TC = (MODE == 0) ? 256 : 192;
    const int kk = tid >> 3, ch = tid & 7;
    const bf16_t* kg = P + (size_t)(u.rowbase + u.rho + u.dil * kk) * NP + u.kcol + ch * 8;
    const bf16_t* vg = P + (size_t)(u.rowbase + u.rho + u.dil * kk) * NP + u.vcol + ch * 8;
    const size_t tstep = (size_t)64 * u.dil * NP;
    u32x4 kreg = *(const u32x4*)(kg + (size_t)u.t_lo * tstep), vreg = *(const u32x4*)(vg + (size_t)u.t_lo * tstep);
    bf16x8 qa[4], qb[4];
#pragma unroll
    for (int ds = 0; ds < 4; ++ds) { qa[ds] = *(const bf16x8*)(P + qrow_a * NP + u.qcol + hq * 64 + ds * 16 + hi * 8); qb[ds] = *(const bf16x8*)(P + qrow_b * NP + u.qcol + hq * 64 + ds * 16 + hi * 8); }
    LAS unsigned char* kst = lds + kk * KP + ch * 16; LAS unsigned char* vst = lds + KBUF + kk * VP + ch * 16;
    *(LAS u32x4*)kst = kreg; *(LAS u32x4*)vst = vreg;
    asm volatile("" :: "v"(qa[0]), "v"(qa[1]), "v"(qa[2]), "v"(qa[3]), "v"(qb[0]), "v"(qb[1]), "v"(qb[2]), "v"(qb[3]));
    const LAS unsigned char* krd = lds + r32 * KP + hi * 16;
    const LAS unsigned char* vrd = lds + KBUF + (4 * hi + ((lane & 15) >> 2)) * VP + ((lane >> 4) & 1) * 32 + (lane & 3) * 8;
    const LAS float* btab = (const LAS float*)(lds + L_TAB) + u.tabidx + hq * TW + TC;
    float m_sink = -1e30f;
    if (MODE == 0) m_sink = p.sink[u.g * 12 + u.kvi * 4 + hq] * LOG2E;
    float ma = m_sink, mb = m_sink, la = 0.f, lb = 0.f;
    f32x16 oa0 = {}, oa1 = {}, ob0 = {}, ob1 = {};
    int wt_lo = u.t_lo, wt_hi = u.t_hi;
    if (MODE != 1) { const int c = (u.i0 >> 6) + sub; wt_lo = c - W / 64 > wt_lo ? c - W / 64 : wt_lo; wt_hi = c + W / 64 < wt_hi ? c + W / 64 : wt_hi; }
    if (true) tile_loop<MODE, false>(u, kg, vg, tstep, kreg, vreg, kst, vst, krd, vrd, btab, iqa, hi, wt_lo, wt_hi, qa, qb, ma, la, mb, lb, oa0, oa1, ob0, ob1);
    else tile_loop<MODE, true>(u, kg, vg, tstep, kreg, vreg, kst, vst, krd, vrd, btab, iqa, hi, wt_lo, wt_hi, qa, qb, ma, la, mb, lb, oa0, oa1, ob0, ob1);
    store_block<MODE>(p, u, oa0, oa1, ma, la, m_sink, qrow_a, hq, hi);
    store_block<MODE>(p, u, ob0, ob1, mb, lb, m_sink, qrow_b, hq, hi);
}

__device__ __forceinline__ void seqblk_decode(int sb, int& rowbase, int& S, int& blk) {
    if (sb < 256) { rowbase = MP + (sb >> 5) * 4096; S = 4096; blk = sb & 31; } else { sb -= 256; rowbase = (sb >> 4) * 2048; S = 2048; blk = sb & 15; }
}
__device__ __forceinline__ void phase(LAS unsigned char* lds, const Params& p, int layer, int cslot, int ubeg, int uend, int tid, int wave, int lane) {
    { const float* gt = (const float*)(p.ws + WS_TAB); LAS float* lt = (LAS float*)(lds + L_TAB);
      for (int i = tid; i < TABA_N + TABC_N; i += NTHREADS) lt[i] = gt[i]; }
    unsigned* ctr = (unsigned*)(p.ws + WS_CTL) + 64 * cslot;
    volatile LAS int* slot = (volatile LAS int*)(lds + L_SLOT);
    int nxt = 0;
    if (tid == 0) { nxt = ubeg + (int)atomicAdd(ctr, 1u); *slot = nxt; }
    __syncthreads();
    int un = *slot;
    while (un < uend) {
        if (tid == 0) nxt = ubeg + (int)atomicAdd(ctr, 1u);
        UnitP u; u.dil = 1; u.rho = 0; u.g = 0; u.kvi = 0; u.tabidx = 0; u.gcol = 0; u.ocol = 0;
        if (un < N_BS + N_BP) {
            int b, kvh, blk, S;
            if (un < N_BS) { b = un / 96; const int rem = un % 96; kvh = rem >> 5; blk = rem & 31; u.rowbase = MP + b * 4096; S = 4096; }
            else { const int v = un - N_BS; b = v / 48; const int rem = v % 48; kvh = rem >> 4; blk = rem & 15; u.rowbase = b * 2048; S = 2048; }
            u.i0 = blk * 128; u.t_lo = 0; u.t_hi = S / 64 - 1; u.qcol = C_QB + kvh * 256; u.kcol = C_KB + kvh * 64; u.vcol = C_VB + kvh * 64; u.gcol = C_GB + kvh * 256; u.ocol = 768 + kvh * 256;
            unit<1>(lds, p, u, tid, wave, lane);
        } else if (un < N_BS + N_BP + N_A) {
            const int v = un - (N_BS + N_BP), sb = v / 3, kvh = v % 3; int S, blk; seqblk_decode(sb, u.rowbase, S, blk);
            u.i0 = blk * 128; u.t_lo = 2 * blk - 2 < 0 ? 0 : 2 * blk - 2; u.t_hi = 2 * blk + 3 > S / 64 - 1 ? S / 64 - 1 : 2 * blk + 3;
            u.qcol = C_QA + kvh * 256; u.kcol = C_KA + kvh * 64; u.vcol = C_VA + kvh * 64; u.gcol = C_GA + kvh * 256; u.ocol = kvh * 256; u.tabidx = kvh * 4 * TABA_W; u.g = layer; u.kvi = kvh;
            unit<0>(lds, p, u, tid, wave, lane);
        } else {
            const int v = un - (N_BS + N_BP + N_A), g = v / 640, r = v % 640, sb = r >> 1, kvi = r & 1; int S, blk; seqblk_decode(sb, u.rowbase, S, blk);
            const int dsh = 2 * g, nb = (S >> dsh) >> 7;
            u.dil = 1 << dsh; u.rho = blk / nb; const int lb = blk % nb; u.i0 = lb * 128; u.t_lo = 2 * lb - 1 < 0 ? 0 : 2 * lb - 1; u.t_hi = 2 * lb + 2 > 2 * nb - 1 ? 2 * nb - 1 : 2 * lb + 2;
            u.qcol = C_QC + (g * 8 + kvi * 4) * 64; u.kcol = C_KC + (g * 2 + kvi) * 64; u.vcol = C_VC + (g * 2 + kvi) * 64; u.tabidx = TABA_N + (g * 8 + kvi * 4) * TABC_W; u.g = g; u.kvi = kvi;
            unit<2>(lds, p, u, tid, wave, lane);
        }
        __syncthreads();
        if (tid == 0) *slot = nxt;
        __syncthreads();
        un = *slot;
    }
}
__device__ __forceinline__ void combine_one(const bf16_t* cs, const float* lse, const bf16_t* P, bf16_t* mix, size_t i) {
    const size_t row = i >> 6; const int hc = (int)(i >> 3) & 7, chk = (int)i & 7;
    const float l0 = lse[row * 8 + hc], l1 = lse[((size_t)MT + row) * 8 + hc], l2 = lse[((size_t)2 * MT + row) * 8 + hc];
    const u32x4 a = *(const u32x4*)(cs + row * 512 + hc * 64 + chk * 8), b = *(const u32x4*)(cs + ((size_t)MT + row) * 512 + hc * 64 + chk * 8),
                c = *(const u32x4*)(cs + ((size_t)2 * MT + row) * 512 + hc * 64 + chk * 8), gt = *(const u32x4*)(P + row * NP + C_GC + hc * 64 + chk * 8);
    const float mx = fmaxf(l0, fmaxf(l1, l2));
    float w0 = __builtin_amdgcn_exp2f(l0 - mx), w1 = __builtin_amdgcn_exp2f(l1 - mx), w2 = __builtin_amdgcn_exp2f(l2 - mx);
    const float inv = 1.0f / (w0 + w1 + w2); w0 *= inv; w1 *= inv; w2 *= inv;
    u32x4 o;
#pragma unroll
    for (int k = 0; k < 4; ++k) {
        const float lo = (w0 * bf_lo(a[k]) + w1 * bf_lo(b[k]) + w2 * bf_lo(c[k])) * bf_lo(gt[k]), hi = (w0 * bf_hi(a[k]) + w1 * bf_hi(b[k]) + w2 * bf_hi(c[k])) * bf_hi(gt[k]);
        o[k] = pk_bf16(lo, hi);
    }
    *(u32x4*)(mix + row * DM + 1536 + hc * 64 + chk * 8) = o;
}
__device__ __forceinline__ void combine_phase(const Params& p, int tid) {
    const bf16_t* cs = (const bf16_t*)(p.ws + WS_CS); const float* lse = (const float*)(p.ws + WS_LSE);
    const bf16_t* P = (const bf16_t*)(p.ws + WS_P); bf16_t* mix = (bf16_t*)(p.ws + WS_H);
    const size_t stride = (size_t)gridDim.x * NTHREADS, total = (size_t)MT * 64;
    size_t i = (size_t)blockIdx.x * NTHREADS + tid;
    for (; i + 3 * stride < total; i += 4 * stride) { combine_one(cs, lse, P, mix, i); combine_one(cs, lse, P, mix, i + stride); combine_one(cs, lse, P, mix, i + 2 * stride); combine_one(cs, lse, P, mix, i + 3 * stride); }
    for (; i < total; i += stride) combine_one(cs, lse, P, mix, i);
}
}

typedef const __attribute__((address_space(4))) Params* KParamsPtr;
__device__ __forceinline__ Params fresh_params() {
#if defined(__HIP_DEVICE_COMPILE__)
    KParamsPtr pp = (KParamsPtr)__builtin_amdgcn_kernarg_segment_ptr(); asm volatile("" : "+s"(pp)); Params r;
    r.x_prompt = pp->x_prompt; r.x_sample = pp->x_sample; r.ln_g = pp->ln_g; r.w_in = pp->w_in; r.qna = pp->qna; r.kna = pp->kna; r.sink = pp->sink; r.qnb = pp->qnb; r.knb = pp->knb;
    r.qnc = pp->qnc; r.knc = pp->knc; r.rel_bias = pp->rel_bias; r.w_out = pp->w_out; r.out = pp->out; r.ws = pp->ws; return r;
#else
    return Params{};
#endif
}
#define PHASE_IDS() int tid_l = threadIdx.x; asm volatile("" : "+v"(tid_l)); const int tid = tid_l, lane = tid & 63, wave = __builtin_amdgcn_readfirstlane(tid >> 6); (void)lane; (void)wave
#define GRID_BAR() xcd_barrier(bar)
__global__ void __launch_bounds__(NTHREADS, 2) fwd_megakernel(Params p_unused) {
    extern __shared__ __attribute__((aligned(16))) unsigned char lds_raw[];
    LAS unsigned char* lds = (LAS unsigned char*)lds_raw;
    if (threadIdx.x < 2) ((volatile LAS unsigned*)(lds + XBAR_LDS))[threadIdx.x] = 0u;
    __syncthreads();
    XcdBarrier bar;
    { const Params p = fresh_params(); bar = xcd_barrier_post((unsigned*)(p.ws + WS_CTL) + CW_BAR, (volatile LAS unsigned*)(lds + XBAR_LDS)); }
#ifndef NO_PRO
    { const Params p = fresh_params(); PHASE_IDS(); prologue_phase(p, lds, tid, wave, lane); }
#endif
#if defined(REP_SYNC)
    for (int i = 0; i < REP_SYNC; ++i) GRID_BAR();
#endif
    for (int layer = 0; layer < 2; ++layer) {
        asm volatile("" : "+s"(layer));
#ifndef NO_NORM
        { const Params p = fresh_params(); PHASE_IDS();
          const float* x0 = layer == 0 ? p.x_prompt : p.out; const float* x1 = layer == 0 ? p.x_sample : p.out + (size_t)MP * DM;
          norm_phase(x0, x1, p.ln_g + layer * DM, (bf16_t*)(p.ws + WS_H), wave, lane); }
#endif
        if (layer == 0) cg::this_grid().sync(); else GRID_BAR();
#if defined(NAIVE_G1)
        { const Params p = fresh_params(); PHASE_IDS(); naive_g1(p, layer, wave, lane); }
#endif
#if defined(NAIVE_G2X)
#endif
#ifndef NO_G1
        { const Params p = fresh_params();
          pg8::Gemm g{(const bf16_t*)(p.ws + WS_H), (const bf16_t*)(p.ws + WS_WIN) + (size_t)layer * NP * DM, MT, NP, DM}; pg8::StaticOrder S; S.init(MT, NP, (int)gridDim.x, (int)blockIdx.x);
          pg8::EpiProj E{(bf16_t*)(p.ws + WS_P), p.qna + layer * 64, p.kna + layer * 64, p.qnb + layer * 64, p.knb + layer * 64, p.qnc + layer * 64, p.knc + layer * 64, (const float*)(p.ws + WS_TAB) + TABA_N + TABC_N};
          pg8::gemm_phase<pg8::EpiProj, pg8::StaticOrder, true, true>(lds, g, S, E);
#if defined(REP_G1)
          pg8::gemm_phase<pg8::EpiProj, pg8::StaticOrder, true, true>(lds, g, S, E);
#endif
        }
#endif
        GRID_BAR();
#ifndef NO_ATT
        { const Params p = fresh_params(); PHASE_IDS(); att::phase(lds, p, layer, layer, 0, att::N_UNITS, tid, wave, lane); }
#if defined(REP_ATT)
        GRID_BAR();
        { const Params p = fresh_params(); PHASE_IDS(); att::phase(lds, p, layer, layer + 2, REP_ATT_LO, REP_ATT_HI, tid, wave, lane); }
#endif
#endif
        GRID_BAR();
#ifndef NO_CMB
        { const Params p = fresh_params(); PHASE_IDS(); att::combine_phase(p, tid); }
#endif
        GRID_BAR();
#if defined(NAIVE_MASK)
        { const Params p = fresh_params(); PHASE_IDS(); naive_attention(p, layer, wave, lane); }
        GRID_BAR();
#endif
#if defined(NAIVE_G2)
        { const Params p = fresh_params(); PHASE_IDS(); naive_g2(p, layer, wave, lane); }
#endif
#ifndef NO_G2
        { const Params p = fresh_params();
          const float* x0 = layer == 0 ? p.x_prompt : p.out; const float* x1 = layer == 0 ? p.x_sample : p.out + (size_t)MP * DM;
          pg8::Gemm g{(const bf16_t*)(p.ws + WS_H), (const bf16_t*)(p.ws + WS_WOUT) + (size_t)layer * DM * DM, MT, DM, DM}; pg8::StaticOrder S; S.init(MT, DM, (int)gridDim.x, (int)blockIdx.x);
          pg8::EpiRes E{x0, x1, p.out};
          pg8::gemm_phase<pg8::EpiRes, pg8::StaticOrder, true, true>(lds, g, S, E); }
#endif
        if (layer == 0) GRID_BAR();
    }
}

extern "C" void kernel_launch(void* const* d_in, const int* in_sizes, int n_in, void* d_out, int out_size, void* d_ws, size_t ws_size, hipStream_t stream) {
    static int grid_blocks = 0;
    if (grid_blocks == 0) {
        if (n_in != 13 || out_size != MT * DM || ws_size < WS_END) { fprintf(stderr, "kernel_launch: unexpected shapes (n_in %d, out %d, ws %zu < %zu)\n", n_in, out_size, ws_size, (size_t)WS_END); grid_blocks = -1; return; }
        int dev = 0, cus = 0, per_cu = 0;
        hipGetDevice(&dev); hipDeviceGetAttribute(&cus, hipDeviceAttributeMultiprocessorCount, dev);
        hipFuncSetAttribute((const void*)fwd_megakernel, hipFuncAttributeMaxDynamicSharedMemorySize, LDS_BYTES);
        hipOccupancyMaxActiveBlocksPerMultiprocessor(&per_cu, (const void*)fwd_megakernel, NTHREADS, LDS_BYTES);
        if (per_cu < 1) { fprintf(stderr, "kernel_launch: occupancy query says %d blocks/CU\n", per_cu); per_cu = 1; }
        (void)hipGetLastError();
        grid_blocks = cus * 1;
    }
    if (grid_blocks < 0) return;
    hipMemsetAsync((char*)d_ws + WS_CTL, 0, CTL_BYTES, stream);
    Params p{};
    p.x_prompt = (const float*)d_in[0]; p.x_sample = (const float*)d_in[1]; p.ln_g = (const float*)d_in[2]; p.w_in = (const float*)d_in[3]; p.qna = (const float*)d_in[4]; p.kna = (const float*)d_in[5];
    p.sink = (const float*)d_in[6]; p.qnb = (const float*)d_in[7]; p.knb = (const float*)d_in[8]; p.qnc = (const float*)d_in[9]; p.knc = (const float*)d_in[10]; p.rel_bias = (const float*)d_in[11];
    p.w_out = (const float*)d_in[12]; p.out = (float*)d_out; p.ws = (unsigned char*)d_ws;
    void* args[] = {&p};
    hipError_t e = hipLaunchCooperativeKernel((const void*)fwd_megakernel, dim3(grid_blocks), dim3(NTHREADS), args, LDS_BYTES, stream);
    if (e != hipSuccess) fprintf(stderr, "cooperative launch failed: %s (grid %d)\n", hipGetErrorString(e), grid_blocks);
}
```

```cpp
#include <hip/hip_runtime.h>
#include <hip/hip_cooperative_groups.h>
#include <cstdio>
#include <cstdint>
namespace cg = cooperative_groups;

constexpr int DM = 2048, NP = 6656, MP = 8192, MS = 32768, MT = MP + MS;
constexpr int C_QA = 0, C_KA = 768, C_VA = 960, C_GA = 1152, C_QB = 1920, C_KB = 2688, C_VB = 2880, C_GB = 3072, C_QC = 3840, C_KC = 5376, C_VC = 5760, C_GC = 6144;
constexpr float QSCALE = 0.125f * 1.4426950408889634f;
constexpr float LOG2E = 1.4426950408889634f;
constexpr float RMS_EPS = 1e-6f;

namespace pg8 {
#define PG8_LAS __attribute__((address_space(3)))
typedef unsigned short bf16_t;
typedef short bf16x8 __attribute__((ext_vector_type(8)));
typedef float f32x4 __attribute__((ext_vector_type(4)));
typedef unsigned u32x4 __attribute__((ext_vector_type(4)));
constexpr int BM = 256, BK = 64, HALF = 128, HTB = HALF * BK * 2  , STAGE_BYTES = 8 * HTB, NXCD = 8, WGM = 8;

__host__ __device__ __forceinline__ int lds_byte(int r, int c) { const int st = (r >> 4) * 2 + (c >> 5), rr = r & 15, cc = c & 31, ob = rr * 64 + cc * 2; return st * 1024 + (ob ^ (((ob >> 9) & 1) << 5)); }
__host__ __device__ __forceinline__ void stage_rc(int b, int& R, int& C) { const int st = b / 1024, sb = b % 1024, swz = sb ^ (((sb >> 9) & 1) << 5); R = (st >> 1) * 16 + swz / 64; C = (st & 1) * 32 + (swz % 64) / 2; }
__host__ __device__ __forceinline__ int perm32(int rho) { const int n = rho >> 4, i = rho & 15; return 8 * (i >> 2) + 4 * n + (i & 3); }

struct Unit { int pm, pn; };
struct Gemm { const bf16_t* A; const bf16_t* Bt; int M, N, K; };

struct StaticOrder {
    int nM, nN, nwg, G, c;
    __host__ __device__ void init(int M, int N, int G_, int c_) { nM = M / BM; nN = N / BM; nwg = nM * nN; G = G_; c = c_; }
    __host__ __device__ bool next(int i, Unit& u) const {
        const long L = (long)i * G + c; if (L >= nwg) return false;
        int wgid = (int)L; { const int q = nwg / NXCD, r = nwg % NXCD, xcd = wgid % NXCD, off = wgid / NXCD; wgid = (xcd < r ? xcd * (q + 1) : r * (q + 1) + (xcd - r) * q) + off; }
        const int nig = WGM * nN, gid = wgid / nig, fm = gid * WGM, gsz = (nM - fm) < WGM ? (nM - fm) : WGM;
        u.pm = fm + ((wgid % nig) % gsz); u.pn = (wgid % nig) / gsz; return true;
    }
    __device__ __forceinline__ void a_ready(const Unit&) const {}
    __device__ __forceinline__ void done(const Unit&) const {}
};

__device__ __forceinline__ unsigned cvt_pk_bf16(float lo, float hi) { unsigned r; asm volatile("v_cvt_pk_bf16_f32 %0, %1, %2" : "=v"(r) : "v"(lo), "v"(hi)); return r; }
typedef float f32x2e __attribute__((ext_vector_type(2)));
struct EpiProj {
    static constexpr bool PERM = true, AFTER_DRAIN = false;
    bf16_t* P; const float *qna, *kna, *qnb, *knb, *qnc, *knc; const float* rope;
    __device__ __forceinline__ void operator()(const f32x4 (&acc)[2][2][4][2], const Unit& u, int wr, int wc, int fr, int fq) const {
        const int hd = u.pn * 4 + wc;
        int type; const float* w = qna; float qs = 1.f;
        if (hd < 12) { type = 2; w = qna; qs = QSCALE; } else if (hd < 15) { type = 2; w = kna; } else if (hd < 18) { type = 0; } else if (hd < 30) { type = 1; }
        else if (hd < 42) { type = 3; w = qnb; qs = QSCALE; } else if (hd < 45) { type = 3; w = knb; } else if (hd < 48) { type = 0; } else if (hd < 60) { type = 1; }
        else if (hd < 84) { type = 2; w = qnc; qs = QSCALE; } else if (hd < 90) { type = 2; w = knc; } else if (hd < 96) { type = 0; } else { type = 1; }
        const int row0 = u.pm * BM + wr * 64 + fr;
        bf16_t* base = P + (size_t)row0 * NP + hd * 64 + 8 * fq;
        if (type == 0) {
#pragma unroll
            for (int ai = 0; ai < 2; ++ai)
#pragma unroll
                for (int m = 0; m < 4; ++m) { bf16_t* rowp = base + (size_t)(ai * HALF + m * 16) * NP;
#pragma unroll
                    for (int bj = 0; bj < 2; ++bj) { const f32x4 v0 = acc[ai][bj][m][0], v1 = acc[ai][bj][m][1]; u32x4 o;
                        o.x = cvt_pk_bf16(v0[0], v0[1]); o.y = cvt_pk_bf16(v0[2], v0[3]); o.z = cvt_pk_bf16(v1[0], v1[1]); o.w = cvt_pk_bf16(v1[2], v1[3]);
                        *(u32x4*)(rowp + bj * 32) = o; } }
        } else if (type == 1) {
#pragma unroll
            for (int ai = 0; ai < 2; ++ai)
#pragma unroll
                for (int m = 0; m < 4; ++m) { bf16_t* rowp = base + (size_t)(ai * HALF + m * 16) * NP;
#pragma unroll
                    for (int bj = 0; bj < 2; ++bj) { f32x4 v[2] = {acc[ai][bj][m][0], acc[ai][bj][m][1]};
#pragma unroll
                        for (int n = 0; n < 2; ++n)
#pragma unroll
                            for (int e = 0; e < 4; ++e) { const float g = v[n][e]; v[n][e] = g * __builtin_amdgcn_rcpf(1.f + __builtin_amdgcn_exp2f(-g * LOG2E)); }
                        u32x4 o; o.x = cvt_pk_bf16(v[0][0], v[0][1]); o.y = cvt_pk_bf16(v[0][2], v[0][3]); o.z = cvt_pk_bf16(v[1][0], v[1][1]); o.w = cvt_pk_bf16(v[1][2], v[1][3]);
                        *(u32x4*)(rowp + bj * 32) = o; } }
        } else {
            f32x4 wv[2][2];
#pragma unroll
            for (int bj = 0; bj < 2; ++bj)
#pragma unroll
                for (int n = 0; n < 2; ++n) wv[bj][n] = *(const f32x4*)(w + 32 * bj + 8 * fq + 4 * n);
            const float sgn = (fq < 2) ? -1.f : 1.f;
#pragma unroll
            for (int ai = 0; ai < 2; ++ai)
#pragma unroll
                for (int m = 0; m < 4; ++m) { bf16_t* rowp = base + (size_t)(ai * HALF + m * 16) * NP;
                    f32x4 v[2][2]; float ss = 0.f;
#pragma unroll
                    for (int bj = 0; bj < 2; ++bj)
#pragma unroll
                        for (int n = 0; n < 2; ++n) { v[bj][n] = acc[ai][bj][m][n]; const f32x4 x = v[bj][n]; ss += (x[0] * x[0] + x[1] * x[1]) + (x[2] * x[2] + x[3] * x[3]); }
                    ss += __shfl_xor(ss, 16); ss += __shfl_xor(ss, 32);
                    const float rs = __builtin_amdgcn_rsqf(ss * (1.0f / 64.0f) + RMS_EPS);
#pragma unroll
                    for (int bj = 0; bj < 2; ++bj)
#pragma unroll
                        for (int n = 0; n < 2; ++n) v[bj][n] = v[bj][n] * rs * wv[bj][n];
                    if (type == 3) {
                        const int r = row0 + ai * HALF + m * 16, t = r & ((r < MP) ? 2047 : 4095);
#pragma unroll
                        for (int bj = 0; bj < 2; ++bj) { const int pos = bj ? (t & 63) : (t >> 6);
#pragma unroll
                            for (int n = 0; n < 2; ++n) { const float* tp = rope + (size_t)(pos * 16 + 8 * (fq & 1) + 4 * n) * 2;
                                const f32x4 cs0 = *(const f32x4*)tp, cs1 = *(const f32x4*)(tp + 4); const f32x4 x = v[bj][n]; f32x4 pr;
                                pr[0] = __shfl_xor(x[0], 32); pr[1] = __shfl_xor(x[1], 32); pr[2] = __shfl_xor(x[2], 32); pr[3] = __shfl_xor(x[3], 32);
                                f32x4 y; y[0] = x[0] * cs0[0] + sgn * pr[0] * cs0[1]; y[1] = x[1] * cs0[2] + sgn * pr[1] * cs0[3];
                                y[2] = x[2] * cs1[0] + sgn * pr[2] * cs1[1]; y[3] = x[3] * cs1[2] + sgn * pr[3] * cs1[3]; v[bj][n] = y; } }
                    }
#pragma unroll
                    for (int bj = 0; bj < 2; ++bj) { const f32x4 v0 = v[bj][0] * qs, v1 = v[bj][1] * qs; u32x4 o;
                        o.x = cvt_pk_bf16(v0[0], v0[1]); o.y = cvt_pk_bf16(v0[2], v0[3]); o.z = cvt_pk_bf16(v1[0], v1[1]); o.w = cvt_pk_bf16(v1[2], v1[3]);
                        *(u32x4*)(rowp + bj * 32) = o; } }
        }
    }
};
struct EpiRes {
    static constexpr bool PERM = true, AFTER_DRAIN = false;
    const float* x0; const float* x1; float* out;
    __device__ __forceinline__ void operator()(const f32x4 (&acc)[2][2][4][2], const Unit& u, int wr, int wc, int fr, int fq) const {
        const int row0 = u.pm * BM + wr * 64 + fr, col0 = u.pn * BM + wc * 32 + 8 * fq;
        const float* xb = (row0 < MP) ? x0 + (size_t)row0 * DM : x1 + (size_t)(row0 - MP) * DM;
        float* ob = out + (size_t)row0 * DM;
#pragma unroll
        for (int ai = 0; ai < 2; ++ai)
#pragma unroll
            for (int m = 0; m < 4; ++m) { const size_t off = (size_t)(ai * HALF + m * 16) * DM + col0;
#pragma unroll
                for (int bj = 0; bj < 2; ++bj) { const f32x4 a0 = *(const f32x4*)(xb + off + bj * HALF), a1 = *(const f32x4*)(xb + off + bj * HALF + 4);
                    *(f32x4*)(ob + off + bj * HALF) = a0 + acc[ai][bj][m][0]; *(f32x4*)(ob + off + bj * HALF + 4) = a1 + acc[ai][bj][m][1]; } }
    }
};

template <class Epi, class Sched, bool ALIGN_EPI = false, bool SP2 = false>
__device__ __forceinline__ void gemm_phase(PG8_LAS unsigned char* lds, const Gemm g, const Sched& S, const Epi& E) {
    int tid_l = threadIdx.x; asm volatile("" : "+v"(tid_l));
    const int tid = tid_l, wid = __builtin_amdgcn_readfirstlane(tid >> 6), lane = tid & 63, wr = wid >> 2, wc = wid & 3, fr = lane & 15, fq = lane >> 4;
    const int K = g.K, nt = K / BK;
    unsigned voffA[2], voffB[2];
#pragma unroll
    for (int i = 0; i < 2; ++i) { int R, C; stage_rc(tid * 16 + i * 8192, R, C); const int Rb = Epi::PERM ? ((R & ~31) + perm32(R & 31)) : R;
        voffA[i] = (unsigned)(R * K + C) * 2u; voffB[i] = (unsigned)(Rb * K + C) * 2u; }
    const size_t kstep = (size_t)(BK * 2);
    const size_t hstep = (size_t)HALF * K * 2;
    const size_t tstep = 2 * hstep;
    const unsigned ldsw = (unsigned)wid * 1024u;
    const int aoff = lds_byte(wr * 64 + fr, fq * 8), boff = lds_byte(wc * 32 + fr, fq * 8);
#define PG8_SA(b, h) (((b) * 2 + (h)) * HTB)
#define PG8_SB(b, h) ((4 + (b) * 2 + (h)) * HTB)
#define PG8_STAGE(bufoff, gbase, voff) do { _Pragma("unroll") for (int _i = 0; _i < 2; ++_i) \
        __builtin_amdgcn_global_load_lds((const unsigned*)((const char*)(gbase) + (voff)[_i]), (PG8_LAS unsigned*)(lds + (bufoff) + ldsw + _i * 8192), 16, 0, 0); } while (0)
#define PG8_LDA(dst, b, h) do { _Pragma("unroll") for (int m = 0; m < 4; ++m) _Pragma("unroll") for (int k = 0; k < 2; ++k) dst[m][k] = *(const PG8_LAS bf16x8*)(lds + PG8_SA(b, h) + aoff + m * 2048 + k * 1024); } while (0)
#define PG8_LDB(dst, b, h) do { _Pragma("unroll") for (int n = 0; n < 2; ++n) _Pragma("unroll") for (int k = 0; k < 2; ++k) dst[n][k] = *(const PG8_LAS bf16x8*)(lds + PG8_SB(b, h) + boff + n * 2048 + k * 1024); } while (0)
#define PG8_MMA(ai, bj, At, Bt) do { __builtin_amdgcn_s_setprio(1); _Pragma("unroll") for (int m = 0; m < 4; ++m) _Pragma("unroll") for (int n = 0; n < 2; ++n) _Pragma("unroll") for (int k = 0; k < 2; ++k) \
        acc[ai][bj][m][n] = __builtin_amdgcn_mfma_f32_16x16x32_bf16(Bt[n][k], At[m][k], acc[ai][bj][m][n], 0, 0, 0); __builtin_amdgcn_s_setprio(0); } while (0)
#define PG8_WAIT_V(n) asm volatile("s_waitcnt vmcnt(" #n ")" ::: "memory")
#define PG8_WAIT_L(n) asm volatile("s_waitcnt lgkmcnt(" #n ")" ::: "memory")
#define PG8_BAR __builtin_amdgcn_s_barrier()
#define PG8_SCHED __builtin_amdgcn_sched_barrier(0)
    Unit cur, nxt; int ui = 0;
    if (!S.next(0, cur)) return;
    f32x4 acc[2][2][4][2];
#pragma unroll
    for (int a = 0; a < 2; ++a)
#pragma unroll
        for (int b = 0; b < 2; ++b)
#pragma unroll
            for (int m = 0; m < 4; ++m)
#pragma unroll
                for (int n = 0; n < 2; ++n) acc[a][b][m][n] = (f32x4){0.f, 0.f, 0.f, 0.f};
    bf16x8 At[4][2], B0[2][2], B1[2][2];
    const char* cA = (const char*)g.A + (size_t)cur.pm * tstep; const char* cB = (const char*)g.Bt + (size_t)cur.pn * tstep;
    S.a_ready(cur);
    if constexpr (SP2) {
        PG8_STAGE(PG8_SB(0, 0), cB, voffB); PG8_STAGE(PG8_SB(0, 1), cB + hstep, voffB); PG8_STAGE(PG8_SA(0, 0), cA, voffA); PG8_STAGE(PG8_SA(0, 1), cA + hstep, voffA);
        if (wr == 1) PG8_BAR;
        PG8_WAIT_V(2); PG8_BAR;
        PG8_STAGE(PG8_SB(1, 0), cB + kstep, voffB); PG8_STAGE(PG8_SA(1, 0), cA + kstep, voffA); PG8_STAGE(PG8_SB(1, 1), cB + hstep + kstep, voffB);
        PG8_WAIT_V(6); PG8_BAR;
    } else {
        PG8_STAGE(PG8_SB(0, 0), cB, voffB); PG8_STAGE(PG8_SA(0, 0), cA, voffA); PG8_STAGE(PG8_SB(0, 1), cB + hstep, voffB); PG8_STAGE(PG8_SA(0, 1), cA + hstep, voffA);
        if (wr == 1) PG8_BAR;
        PG8_WAIT_V(4); PG8_BAR;
        PG8_STAGE(PG8_SB(1, 0), cB + kstep, voffB); PG8_STAGE(PG8_SA(1, 0), cA + kstep, voffA); PG8_STAGE(PG8_SB(1, 1), cB + hstep + kstep, voffB);
        PG8_WAIT_V(6); PG8_BAR;
    }
    for (;;) {
        const bool has_next = S.next(ui + 1, nxt);
        const char* nA = has_next ? (const char*)g.A + (size_t)nxt.pm * tstep : cA; const char* nB = has_next ? (const char*)g.Bt + (size_t)nxt.pn * tstep : cB;
        for (int t = 0; t < nt; t += 2) {
            const bool last = (t == nt - 2);
            const char* a1 = cA + (size_t)(t + 1) * kstep;
            const char* a2 = last ? nA : cA + (size_t)(t + 2) * kstep; const char* b2 = last ? nB : cB + (size_t)(t + 2) * kstep;
            const char* a3 = a2 + kstep; const char* b3 = b2 + kstep;
            if (last && has_next) S.a_ready(nxt);
            if constexpr (SP2) {
            PG8_LDB(B0, 0, 0); PG8_LDB(B1, 0, 1); PG8_SCHED; PG8_LDA(At, 0, 0); PG8_STAGE(PG8_SA(1, 1), a1 + hstep, voffA);
            PG8_WAIT_V(8); PG8_WAIT_L(0); PG8_BAR; PG8_MMA(0, 0, At, B0); PG8_MMA(0, 1, At, B1); PG8_BAR; PG8_SCHED;
            PG8_LDA(At, 0, 1); PG8_STAGE(PG8_SB(0, 0), b2, voffB); PG8_STAGE(PG8_SB(0, 1), b2 + hstep, voffB); PG8_STAGE(PG8_SA(0, 0), a2, voffA);
            PG8_WAIT_V(8); PG8_WAIT_L(0); PG8_BAR; PG8_MMA(1, 0, At, B0); PG8_MMA(1, 1, At, B1); PG8_BAR; PG8_SCHED;
            PG8_LDB(B0, 1, 0); PG8_LDB(B1, 1, 1); PG8_SCHED; PG8_LDA(At, 1, 0); PG8_STAGE(PG8_SA(0, 1), a2 + hstep, voffA);
            PG8_WAIT_V(8); PG8_WAIT_L(0); PG8_BAR; PG8_MMA(0, 0, At, B0); PG8_MMA(0, 1, At, B1); PG8_BAR; PG8_SCHED;
            PG8_LDA(At, 1, 1); PG8_STAGE(PG8_SB(1, 0), b3, voffB); PG8_STAGE(PG8_SB(1, 1), b3 + hstep, voffB); PG8_STAGE(PG8_SA(1, 0), a3, voffA);
            PG8_WAIT_V(8); PG8_WAIT_L(0); PG8_BAR; PG8_MMA(1, 0, At, B0); PG8_MMA(1, 1, At, B1); PG8_BAR; PG8_SCHED;
            } else {
            PG8_LDB(B0, 0, 0); PG8_SCHED; PG8_LDA(At, 0, 0); PG8_STAGE(PG8_SA(1, 1), a1 + hstep, voffA);
            PG8_WAIT_L(8); PG8_BAR; PG8_WAIT_L(0); PG8_MMA(0, 0, At, B0); PG8_BAR; PG8_SCHED;
            PG8_LDB(B1, 0, 1); PG8_STAGE(PG8_SB(0, 0), b2, voffB);
            PG8_BAR; PG8_WAIT_L(0); PG8_MMA(0, 1, At, B1); PG8_BAR;
            PG8_LDA(At, 0, 1); PG8_STAGE(PG8_SA(0, 0), a2, voffA);
            PG8_BAR; PG8_WAIT_L(0); PG8_MMA(1, 0, At, B0); PG8_BAR; PG8_SCHED;
            PG8_STAGE(PG8_SB(0, 1), b2 + hstep, voffB);
            PG8_WAIT_V(6); PG8_BAR; PG8_MMA(1, 1, At, B1); PG8_BAR;
            PG8_LDB(B0, 1, 0); PG8_SCHED; PG8_LDA(At, 1, 0); PG8_STAGE(PG8_SA(0, 1), a2 + hstep, voffA);
            PG8_WAIT_L(8); PG8_BAR; PG8_WAIT_L(0); PG8_MMA(0, 0, At, B0); PG8_BAR; PG8_SCHED;
            PG8_LDB(B1, 1, 1); PG8_STAGE(PG8_SB(1, 0), b3, voffB);
            PG8_BAR; PG8_WAIT_L(0); PG8_MMA(0, 1, At, B1); PG8_BAR;
            PG8_LDA(At, 1, 1); PG8_STAGE(PG8_SA(1, 0), a3, voffA);
            PG8_BAR; PG8_WAIT_L(0); PG8_MMA(1, 0, At, B0); PG8_BAR; PG8_SCHED;
            PG8_STAGE(PG8_SB(1, 1), b3 + hstep, voffB);
            PG8_WAIT_V(6); PG8_BAR; PG8_MMA(1, 1, At, B1); PG8_BAR;
            }
        }
        if constexpr (ALIGN_EPI) { if (wr == 0) PG8_BAR; }
        if constexpr (!Epi::AFTER_DRAIN) { E(acc, cur, wr, wc, fr, fq); S.done(cur); }
        if (!has_next) break;
#pragma unroll
        for (int a = 0; a < 2; ++a)
#pragma unroll
            for (int b = 0; b < 2; ++b)
#pragma unroll
                for (int m = 0; m < 4; ++m)
#pragma unroll
                    for (int n = 0; n < 2; ++n) acc[a][b][m][n] = (f32x4){0.f, 0.f, 0.f, 0.f};
        cur = nxt; cA = nA; cB = nB; ++ui;
        if constexpr (ALIGN_EPI) { if (wr == 1) PG8_BAR; }
    }
    PG8_WAIT_V(0);
    if constexpr (!ALIGN_EPI) { if (wr == 0) PG8_BAR; }
    PG8_BAR;
    if constexpr (Epi::AFTER_DRAIN) { E.fused(acc, cur, wr, wc, fr, fq, lds, wid, lane); S.done(cur); }
#undef PG8_SA
#undef PG8_SB
#undef PG8_STAGE
#undef PG8_LDA
#undef PG8_LDB
#undef PG8_MMA
#undef PG8_WAIT_V
#undef PG8_WAIT_L
#undef PG8_BAR
#undef PG8_SCHED
}
}

#define LAS __attribute__((address_space(3)))
typedef unsigned short bf16_t;
typedef short bf16x8 __attribute__((ext_vector_type(8)));
typedef short s16x4 __attribute__((ext_vector_type(4)));
typedef float f32x4 __attribute__((ext_vector_type(4)));
typedef float f32x16 __attribute__((ext_vector_type(16)));
typedef unsigned u32x4 __attribute__((ext_vector_type(4)));
typedef unsigned u32x2 __attribute__((ext_vector_type(2)));
constexpr int NWAVES = 8, NTHREADS = 512;
constexpr int LDS_BYTES = 139264;
__device__ __forceinline__ unsigned pk_bf16(float lo, float hi) { unsigned r; asm volatile("v_cvt_pk_bf16_f32 %0, %1, %2" : "=v"(r) : "v"(lo), "v"(hi)); return r; }
__device__ __forceinline__ float bf_lo(unsigned w) { return __uint_as_float(w << 16); }
__device__ __forceinline__ float bf_hi(unsigned w) { return __uint_as_float(w & 0xffff0000u); }

constexpr size_t WS_CTL = 0, CTL_BYTES = 32768;
constexpr int CW_BAR = 4096, XBAR_LDS = 131072 + 512;
constexpr size_t WS_TAB = 65536;
constexpr int TABA_W = 513, TABC_W = 385, TABA_N = 12 * TABA_W, TABC_N = 24 * TABC_W, ROPE_N = 64 * 16 * 2;
constexpr size_t WS_WIN = 1u << 20;
constexpr size_t WS_WOUT = WS_WIN + (size_t)2 * NP * DM * 2;
constexpr size_t WS_H = WS_WOUT + (size_t)2 * DM * DM * 2;
constexpr size_t WS_P = WS_H + (size_t)MT * DM * 2;
constexpr size_t WS_CS = WS_P + (size_t)MT * NP * 2;
constexpr size_t WS_LSE = WS_CS + (size_t)3 * MT * 512 * 2;
constexpr size_t WS_END = WS_LSE + (size_t)3 * MT * 8 * 4;

__constant__ float INVF[16] = {1.0f, 0.5623413251903491f, 0.31622776601683794f, 0.1778279410038923f, 0.1f, 0.05623413251903491f, 0.03162277660168379f, 0.01778279410038923f,
                               0.01f, 0.005623413251903491f, 0.0031622776601683794f, 0.0017782794100389228f, 0.001f, 0.0005623413251903491f, 0.00031622776601683794f, 0.00017782794100389227f};

struct Params {
    const float* x_prompt; const float* x_sample; const float* ln_g; const float* w_in; const float* qna; const float* kna; const float* sink; const float* qnb; const float* knb;
    const float* qnc; const float* knc; const float* rel_bias; const float* w_out; float* out; unsigned char* ws;
};

__device__ __forceinline__ int t5_bucket(int rel) {
    const int n = rel < 0 ? -rel : rel;
    const int large = 8 + (n >= 15) + (n >= 27) + (n >= 50) + (n >= 91) + (n >= 166) + (n >= 305) + (n >= 559);
    return (rel > 0 ? 16 : 0) + (n < 8 ? n : large);
}
template <bool PERMUTE>
__device__ __forceinline__ void transpose_item(const float* W, int K, int N, bf16_t* WT, LAS float* scr, int item, int lane) {
    const int nblk = N / 32, kb = item / nblk, nb = item % nblk, k0 = 64 * kb, n0 = 32 * nb;
    float wv[32];
#pragma unroll
    for (int i = 0; i < 32; ++i) wv[i] = W[(size_t)(k0 + 2 * i + (lane >> 5)) * N + n0 + (lane & 31)];
#pragma unroll
    for (int i = 0; i < 32; ++i) scr[(2 * i + (lane >> 5)) * 33 + (lane & 31)] = wv[i];
    asm volatile("s_waitcnt lgkmcnt(0)" ::: "memory");
    const int c = lane & 7;
    const int r0 = PERMUTE ? (256 * (n0 >> 8) + 128 * ((n0 >> 5) & 1) + 32 * ((n0 >> 6) & 3)) : n0;
#pragma unroll
    for (int j = 0; j < 4; ++j) { const int n = (lane >> 3) + 8 * j; const LAS float* s = scr + (8 * c) * 33 + n;
        u32x4 o; o.x = pk_bf16(s[0 * 33], s[1 * 33]); o.y = pk_bf16(s[2 * 33], s[3 * 33]); o.z = pk_bf16(s[4 * 33], s[5 * 33]); o.w = pk_bf16(s[6 * 33], s[7 * 33]);
        *(u32x4*)(WT + (size_t)(r0 + n) * K + k0 + 8 * c) = o; }
    asm volatile("s_waitcnt lgkmcnt(0)" ::: "memory");
}
__device__ __forceinline__ void prologue_phase(const Params& p, LAS unsigned char* lds, int tid, int wave, int lane) {
    LAS float* scr = (LAS float*)(lds + wave * 16384);
    const int gw = blockIdx.x * NWAVES + wave, NGW = gridDim.x * NWAVES;
    constexpr int I_IN = (DM / 64) * (NP / 32), I_OUT = (DM / 64) * (DM / 32);
    bf16_t* win = (bf16_t*)(p.ws + WS_WIN); bf16_t* wout = (bf16_t*)(p.ws + WS_WOUT);
    for (int it = gw; it < 2 * (I_IN + I_OUT); it += NGW) {
        int r = it;
        if (r < 2 * I_IN) { const int l = r / I_IN; r -= l * I_IN; transpose_item<true>(p.w_in + (size_t)l * DM * NP, DM, NP, win + (size_t)l * NP * DM, scr, r, lane); }
        else { r -= 2 * I_IN; const int l = r / I_OUT; r -= l * I_OUT; transpose_item<false>(p.w_out + (size_t)l * DM * DM, DM, DM, wout + (size_t)l * DM * DM, scr, r, lane); }
    }
    float* tab = (float*)(p.ws + WS_TAB);
    if (blockIdx.x == 0 && tid < 2) {
        const int l = tid; float mb = 0.f, ms = 0.f;
        for (int i = 0; i < 32 * 36; ++i) mb = fmaxf(mb, fabsf(p.rel_bias[i]));
        for (int i = 0; i < 12; ++i) ms = fmaxf(ms, fabsf(p.sink[l * 12 + i]));
        float qa = 0.f, ka = 0.f, qb = 0.f, kb = 0.f, qc = 0.f, kc = 0.f;
        for (int i = 0; i < 64; ++i) { qa = fmaxf(qa, fabsf(p.qna[l * 64 + i])); ka = fmaxf(ka, fabsf(p.kna[l * 64 + i])); qb = fmaxf(qb, fabsf(p.qnb[l * 64 + i]));
            kb = fmaxf(kb, fabsf(p.knb[l * 64 + i])); qc = fmaxf(qc, fabsf(p.qnc[l * 64 + i])); kc = fmaxf(kc, fabsf(p.knc[l * 64 + i])); }
        const float c = 64.f * QSCALE * 1.02f;
        const bool ok = (mb * LOG2E <= 8.f) && (ms * LOG2E <= 60.f) && (c * qa * ka <= 52.f) && (c * qb * kb <= 52.f) && (c * qc * kc <= 52.f);
        ((int*)tab)[TABA_N + TABC_N + ROPE_N + l] = ok ? 1 : 0;
    }
    for (int i = blockIdx.x * NTHREADS + tid; i < TABA_N + TABC_N + ROPE_N / 2; i += gridDim.x * NTHREADS) {
        if (i < TABA_N) { const int h = i / TABA_W, rel = i % TABA_W - 256; tab[i] = (rel >= -128 && rel <= 128) ? p.rel_bias[t5_bucket(rel) * 36 + h] * LOG2E : -INFINITY; }
        else if (i < TABA_N + TABC_N) { const int j = i - TABA_N, gh = j / TABC_W, rel = j % TABC_W - 192, g = gh >> 3; const int dil = (g == 0) ? 1 : (g == 1 ? 4 : 16);
            tab[i] = (rel >= -64 && rel <= 64) ? p.rel_bias[t5_bucket(rel * dil) * 36 + 12 + gh] * LOG2E : -INFINITY; }
        else { const int j = i - TABA_N - TABC_N, pos = j >> 4, f = j & 15; const float ang = (float)pos * INVF[f];
            tab[TABA_N + TABC_N + 2 * j] = cosf(ang); tab[TABA_N + TABC_N + 2 * j + 1] = sinf(ang); }
    }
}
__device__ __forceinline__ void norm_phase(const float* x0, const float* x1, const float* g, bf16_t* H, int wave, int lane) {
    const int gw = blockIdx.x * NWAVES + wave, NGW = gridDim.x * NWAVES;
    f32x4 nx[8];
    { const f32x4* xr = (const f32x4*)((gw < MP) ? x0 + (size_t)gw * DM : x1 + (size_t)(gw - MP) * DM) + lane;
#pragma unroll
      for (int j = 0; j < 8; ++j) nx[j] = xr[64 * j]; }
    for (int row = gw; row < MT; row += NGW) {
        f32x4 v[8]; float s = 0.f;
#pragma unroll
        for (int j = 0; j < 8; ++j) v[j] = nx[j];
        const int nr = row + NGW;
        if (nr < MT) { const f32x4* xr = (const f32x4*)((nr < MP) ? x0 + (size_t)nr * DM : x1 + (size_t)(nr - MP) * DM) + lane;
#pragma unroll
            for (int j = 0; j < 8; ++j) nx[j] = xr[64 * j]; }
#pragma unroll
        for (int j = 0; j < 8; ++j) s += (v[j][0] * v[j][0] + v[j][1] * v[j][1]) + (v[j][2] * v[j][2] + v[j][3] * v[j][3]);
#pragma unroll
        for (int o = 1; o < 64; o <<= 1) s += __shfl_xor(s, o);
        const float rs = 1.0f / sqrtf(s * (1.0f / DM) + RMS_EPS);
        u32x2* o8 = (u32x2*)(H + (size_t)row * DM) + lane;
#pragma unroll
        for (int j = 0; j < 8; ++j) { const f32x4 gv = ((const f32x4*)g)[lane + 64 * j]; u32x2 o;
            o.x = pk_bf16(v[j][0] * rs * gv[0], v[j][1] * rs * gv[1]); o.y = pk_bf16(v[j][2] * rs * gv[2], v[j][3] * rs * gv[3]); o8[64 * j] = o; }
    }
}

#define XB_TMO      128
#define XB_XCNT(j)  (256  + 64 * (j))
#define XB_XSUB(j)  (1280 + 64 * (j))
#define XB_XGEN(j)  (2304 + 64 * (j))
#define XB_TOP      3328
#define XB_TOPGEN   3392
#define XCD_BAR_WORDS 3456
#define XB_SPIN_CAP (1u << 18)

__device__ __forceinline__ unsigned xb_ld(unsigned* p)              { return __hip_atomic_load(p, __ATOMIC_RELAXED, __HIP_MEMORY_SCOPE_AGENT); }
__device__ __forceinline__ unsigned xb_add(unsigned* p, unsigned v) { return __hip_atomic_fetch_add(p, v, __ATOMIC_RELAXED, __HIP_MEMORY_SCOPE_AGENT); }
__device__ __forceinline__ unsigned xb_xcc_id() { return (unsigned)__builtin_amdgcn_s_getreg((3 << 11) | 20) & 0xFu; }
#define XB_SPIN(cond, bar) do { unsigned _sp = 0; while (cond) { __builtin_amdgcn_s_sleep(1); \
    if ((++_sp & 255u) == 0u) { if (xb_ld(&(bar)[XB_TMO])) break; if (_sp > XB_SPIN_CAP) { atomicAdd(&(bar)[XB_TMO], 1u); break; } } } } while (0)

struct XcdBarrier {
    unsigned* bar; unsigned x;
    volatile LAS unsigned* st;
};

__device__ __forceinline__ XcdBarrier xcd_barrier_post(unsigned* bar, volatile LAS unsigned* st) {
    XcdBarrier b; b.bar = bar; b.x = xb_xcc_id(); b.st = st;
    if (threadIdx.x == 0) (void)xb_add(&bar[XB_XCNT(b.x)], 1u);
    return b;
}
__device__ __forceinline__ void xcd_barrier_complete(unsigned* bar, unsigned x, unsigned& nloc, unsigned& nx) {
    const unsigned G = gridDim.x * gridDim.y * gridDim.z;
    unsigned sum, cnt, mine, sp = 0u;
    for (;;) {
        sum = 0u; cnt = 0u; mine = 0u;
#pragma unroll
        for (unsigned j = 0; j < 16; ++j) { const unsigned c = xb_ld(&bar[XB_XCNT(j)]); sum += c; cnt += (c > 0u) ? 1u : 0u; mine = (j == x) ? c : mine; }
        if (sum == G) break;
        __builtin_amdgcn_s_sleep(1);
        if ((++sp & 255u) == 0u) { if (xb_ld(&bar[XB_TMO])) break; if (sp > XB_SPIN_CAP) { atomicAdd(&bar[XB_TMO], 1u); break; } }
    }
    nloc = mine > 0u ? mine : 1u; nx = cnt > 0u ? cnt : 1u;
}

__device__ __forceinline__ void xcd_barrier(const XcdBarrier& b) {
    asm volatile("s_waitcnt vmcnt(0)" ::: "memory");
    __syncthreads();
    if (threadIdx.x == 0) {
        unsigned* bar = b.bar;
        __builtin_amdgcn_s_waitcnt(0);
        unsigned nloc = b.st[0], nx = b.st[1];
        if (nloc == 0u) { xcd_barrier_complete(bar, b.x, nloc, nx); b.st[0] = nloc; b.st[1] = nx; }
        const unsigned old = xb_add(&bar[XB_XSUB(b.x)], 1u);
        const unsigned gen = old / nloc;
        if (old + 1u == (gen + 1u) * nloc) {
            __builtin_amdgcn_fence(__ATOMIC_RELEASE, "agent");
            asm volatile("s_waitcnt vmcnt(0)" ::: "memory");
            const unsigned og = xb_add(&bar[XB_TOP], 1u);
            const unsigned tg = og / nx;
            if (og + 1u == (tg + 1u) * nx) xb_add(&bar[XB_TOPGEN], 1u);
            else XB_SPIN(xb_ld(&bar[XB_TOPGEN]) == tg, bar);
            __builtin_amdgcn_fence(__ATOMIC_ACQUIRE, "agent");
            xb_add(&bar[XB_XGEN(b.x)], 1u);
            asm volatile("s_waitcnt vmcnt(0)" ::: "memory");
        } else {
            XB_SPIN(xb_ld(&bar[XB_XGEN(b.x)]) == gen, bar);
            __builtin_amdgcn_fence(__ATOMIC_ACQUIRE, "agent");
            asm volatile("s_waitcnt vmcnt(0)" ::: "memory");
        }
    }
    __syncthreads();
}
namespace att {
constexpr int KP = 144, VP = 192, KBUF = 64 * KP, VBUF = 64 * VP, BUFB = KBUF + VBUF;
constexpr int L_TAB = 2 * BUFB, L_SLOT = L_TAB + (TABA_N + TABC_N) * 4;
static_assert(L_SLOT + 64 <= LDS_BYTES, "attention LDS map");
constexpr int N_BS = 768, N_BP = 192, N_A = 960, N_C = 1920, N_UNITS = N_BS + N_BP + N_A + N_C;
constexpr float THR = 5.0f;
typedef short v4i16_t __attribute__((ext_vector_type(4)));
__device__ __forceinline__ s16x4 vtr(const LAS unsigned char* p) { return __builtin_bit_cast(s16x4, __builtin_amdgcn_ds_read_tr16_b64_v4i16((LAS v4i16_t*)p)); }
#define MFMA32(a, b, c) __builtin_amdgcn_mfma_f32_32x32x16_bf16((a), (b), (c), 0, 0, 0)

struct UnitP { int rowbase, dil, rho, i0, t_lo, t_hi, qcol, kcol, vcol, gcol, ocol, tabidx, g, kvi; };

template <bool FAST>
__device__ __forceinline__ void softmax_step(f32x16& p0, f32x16& p1, float& m, float& l, f32x16& o0, f32x16& o1) {
    if (FAST) {
        float ls0 = 0.f, ls1 = 0.f;
#pragma unroll
        for (int r = 0; r < 16; ++r) { p0[r] = __builtin_amdgcn_exp2f(p0[r]); p1[r] = __builtin_amdgcn_exp2f(p1[r]); ls0 += p0[r]; ls1 += p1[r]; }
        l += ls0 + ls1;
        return;
    }
    float a = fmaxf(fmaxf(p0[0], p0[1]), p1[0]), b = fmaxf(fmaxf(p0[2], p0[3]), p1[1]); a = fmaxf(fmaxf(a, p1[2]), p1[3]);
#pragma unroll
    for (int r = 4; r < 16; r += 4) { a = fmaxf(fmaxf(a, p0[r]), p0[r + 1]); b = fmaxf(fmaxf(b, p0[r + 2]), p0[r + 3]); a = fmaxf(fmaxf(a, p1[r]), p1[r + 1]); b = fmaxf(fmaxf(b, p1[r + 2]), p1[r + 3]); }
    float rm = fmaxf(a, b);
    { auto rr = __builtin_amdgcn_permlane32_swap(__float_as_uint(rm), __float_as_uint(rm), false, false); rm = fmaxf(__uint_as_float(rr[0]), __uint_as_float(rr[1])); }
    if (__any(rm > m + THR)) { const float mn = fmaxf(m, rm), al = __builtin_amdgcn_exp2f(m - mn); m = mn; l *= al; o0 = o0 * al; o1 = o1 * al; }
    float ls0 = 0.f, ls1 = 0.f;
#pragma unroll
    for (int r = 0; r < 16; ++r) { p0[r] = __builtin_amdgcn_exp2f(p0[r] - m); p1[r] = __builtin_amdgcn_exp2f(p1[r] - m); ls0 += p0[r]; ls1 += p1[r]; }
    l += ls0 + ls1;
}
__device__ __forceinline__ bf16x8 pack8(const f32x16& x, int s) {
    u32x4 w; w.x = pk_bf16(x[8 * s], x[8 * s + 1]); w.y = pk_bf16(x[8 * s + 2], x[8 * s + 3]); w.z = pk_bf16(x[8 * s + 4], x[8 * s + 5]); w.w = pk_bf16(x[8 * s + 6], x[8 * s + 7]);
    return __builtin_bit_cast(bf16x8, w);
}
template <int MODE>
__device__ __forceinline__ void store_block(const Params& p, const UnitP& u, const f32x16& o0, const f32x16& o1, float m, float l, float m_sink, size_t qrow, int hq, int hi) {
    const bf16_t* __restrict__ P = (const bf16_t*)(p.ws + WS_P);
    float lt; { auto rr = __builtin_amdgcn_permlane32_swap(__float_as_uint(l), __float_as_uint(l), false, false); lt = __uint_as_float(rr[0]) + __uint_as_float(rr[1]); }
    if (MODE == 0) lt += __builtin_amdgcn_exp2f(m_sink - m);
    const float inv = __builtin_amdgcn_rcpf(lt);
    if (MODE != 2) {
        bf16_t* mix = (bf16_t*)(p.ws + WS_H) + qrow * DM + u.ocol + hq * 64 + 4 * hi;
        const bf16_t* gp = P + qrow * NP + u.gcol + hq * 64 + 4 * hi;
#pragma unroll
        for (int g = 0; g < 4; ++g) {
            const u32x2 g0 = *(const u32x2*)(gp + 8 * g), g1 = *(const u32x2*)(gp + 32 + 8 * g); u32x2 w0, w1;
            w0.x = pk_bf16(o0[4 * g] * inv * bf_lo(g0.x), o0[4 * g + 1] * inv * bf_hi(g0.x)); w0.y = pk_bf16(o0[4 * g + 2] * inv * bf_lo(g0.y), o0[4 * g + 3] * inv * bf_hi(g0.y));
            w1.x = pk_bf16(o1[4 * g] * inv * bf_lo(g1.x), o1[4 * g + 1] * inv * bf_hi(g1.x)); w1.y = pk_bf16(o1[4 * g + 2] * inv * bf_lo(g1.y), o1[4 * g + 3] * inv * bf_hi(g1.y));
            *(u32x2*)(mix + 8 * g) = w0; *(u32x2*)(mix + 32 + 8 * g) = w1;
        }
    } else {
        bf16_t* cs = (bf16_t*)(p.ws + WS_CS) + ((size_t)u.g * MT + qrow) * 512 + (u.kvi * 4 + hq) * 64 + 4 * hi;
#pragma unroll
        for (int g = 0; g < 4; ++g) { u32x2 w0, w1;
            w0.x = pk_bf16(o0[4 * g] * inv, o0[4 * g + 1] * inv); w0.y = pk_bf16(o0[4 * g + 2] * inv, o0[4 * g + 3] * inv);
            w1.x = pk_bf16(o1[4 * g] * inv, o1[4 * g + 1] * inv); w1.y = pk_bf16(o1[4 * g + 2] * inv, o1[4 * g + 3] * inv);
            *(u32x2*)(cs + 8 * g) = w0; *(u32x2*)(cs + 32 + 8 * g) = w1; }
        if (hi == 0) ((float*)(p.ws + WS_LSE))[((size_t)u.g * MT + qrow) * 8 + u.kvi * 4 + hq] = m + __builtin_amdgcn_logf(lt);
    }
}
template <int MODE, bool SEQ, bool FAST>
__device__ __forceinline__ void tile_loop(const UnitP& u, const bf16_t* kg, const bf16_t* vg, size_t tstep, u32x4 kreg, u32x4 vreg, LAS unsigned char* kst, LAS unsigned char* vst,
                                          const LAS unsigned char* krd, const LAS unsigned char* vrd, const LAS float* btab, int iqa, int hi, int wt_lo, int wt_hi,
                                          const bf16x8 (&qa)[4], const bf16x8 (&qb)[4], float& ma, float& la, float& mb, float& lb, f32x16& oa0, f32x16& oa1, f32x16& ob0, f32x16& ob1) {
    for (int t = u.t_lo; t <= u.t_hi; ++t) {
        const int boff = ((t - u.t_lo) & 1) * BUFB;
        __syncthreads();
        if (t < u.t_hi) { kreg = *(const u32x4*)(kg + (size_t)(t + 1) * tstep); vreg = *(const u32x4*)(vg + (size_t)(t + 1) * tstep); }
        if (MODE == 1 || (t >= wt_lo && t <= wt_hi)) {
          const LAS float* bt = btab + (64 * t - iqa + 4 * hi);
          if (!SEQ) {
            f32x16 pa0 = {}, pa1 = {}, pb0 = {}, pb1 = {};
#pragma unroll
            for (int ds = 0; ds < 4; ++ds) {
                const bf16x8 k0 = *(const LAS bf16x8*)(krd + boff + ds * 32), k1 = *(const LAS bf16x8*)(krd + boff + 32 * KP + ds * 32);
                pa0 = MFMA32(k0, qa[ds], pa0); pa1 = MFMA32(k1, qa[ds], pa1); pb0 = MFMA32(k0, qb[ds], pb0); pb1 = MFMA32(k1, qb[ds], pb1);
            }
            __builtin_amdgcn_sched_barrier(0);
            if (MODE != 1) {
#pragma unroll
                for (int r = 0; r < 16; ++r) { const int o = (r & 3) + 8 * (r >> 2);
                    pa0[r] += bt[o]; pa1[r] += bt[o + 32]; pb0[r] += bt[o - 32]; pb1[r] += bt[o]; }
            }
            softmax_step<FAST>(pa0, pa1, ma, la, oa0, oa1);
            softmax_step<FAST>(pb0, pb1, mb, lb, ob0, ob1);
            __builtin_amdgcn_sched_barrier(0);
#pragma unroll
            for (int s = 0; s < 4; ++s) {
                const bf16x8 xa = (s < 2) ? pack8(pa0, s & 1) : pack8(pa1, s & 1), xb = (s < 2) ? pack8(pb0, s & 1) : pack8(pb1, s & 1);
                const LAS unsigned char* vb = vrd + boff + s * 16 * VP;
                const s16x4 a0 = vtr(vb), a1 = vtr(vb + 8 * VP), b0 = vtr(vb + 64), b1 = vtr(vb + 8 * VP + 64);
                const bf16x8 vf0 = __builtin_shufflevector(a0, a1, 0, 1, 2, 3, 4, 5, 6, 7), vf1 = __builtin_shufflevector(b0, b1, 0, 1, 2, 3, 4, 5, 6, 7);
                oa0 = MFMA32(vf0, xa, oa0); oa1 = MFMA32(vf1, xa, oa1); ob0 = MFMA32(vf0, xb, ob0); ob1 = MFMA32(vf1, xb, ob1);
                if (s == 1) __builtin_amdgcn_sched_barrier(0);
            }
          } else {
#define ATT_ONE_BLOCK(QF, M_, L_, O0, O1, BOFS) do { \
            f32x16 p0 = {}, p1 = {}; \
            _Pragma("unroll") for (int ds = 0; ds < 4; ++ds) { \
                const bf16x8 k0 = *(const LAS bf16x8*)(krd + boff + ds * 32), k1 = *(const LAS bf16x8*)(krd + boff + 32 * KP + ds * 32); \
                p0 = MFMA32(k0, QF[ds], p0); p1 = MFMA32(k1, QF[ds], p1); } \
            __builtin_amdgcn_sched_barrier(0); \
            if (MODE != 1) { _Pragma("unroll") for (int r = 0; r < 16; ++r) { const int o = (r & 3) + 8 * (r >> 2); p0[r] += bt[o + (BOFS)]; p1[r] += bt[o + 32 + (BOFS)]; } } \
            softmax_step<FAST>(p0, p1, M_, L_, O0, O1); \
            __builtin_amdgcn_sched_barrier(0); \
            _Pragma("unroll") for (int s = 0; s < 4; ++s) { \
                const bf16x8 xs = (s < 2) ? pack8(p0, s & 1) : pack8(p1, s & 1); \
                const LAS unsigned char* vb = vrd + boff + s * 16 * VP; \
                const s16x4 a0 = vtr(vb), a1 = vtr(vb + 8 * VP), b0 = vtr(vb + 64), b1 = vtr(vb + 8 * VP + 64); \
                const bf16x8 vf0 = __builtin_shufflevector(a0, a1, 0, 1, 2, 3, 4, 5, 6, 7), vf1 = __builtin_shufflevector(b0, b1, 0, 1, 2, 3, 4, 5, 6, 7); \
                O0 = MFMA32(vf0, xs, O0); O1 = MFMA32(vf1, xs, O1); } \
            __builtin_amdgcn_sched_barrier(0); } while (0)
            ATT_ONE_BLOCK(qa, ma, la, oa0, oa1, 0);
            ATT_ONE_BLOCK(qb, mb, lb, ob0, ob1, -32);
#undef ATT_ONE_BLOCK
          }
        }
        if (t < u.t_hi) { *(LAS u32x4*)(kst + (BUFB - boff)) = kreg; *(LAS u32x4*)(vst + (BUFB - boff)) = vreg; }
    }
}
template <int MODE, bool FAST>
__device__ __forceinline__ void unit(LAS unsigned char* lds, const Params& p, const UnitP& u, int tid, int wave, int lane) {
    const bf16_t* __restrict__ P = (const bf16_t*)(p.ws + WS_P);
    const int r32 = lane & 31, hi = lane >> 5, hq = wave >> 1, sub = wave & 1;
    const int iqa = u.i0 + 64 * sub + r32;
    const size_t qrow_a = (size_t)(u.rowbase + u.rho + u.dil * iqa), qrow_b = qrow_a + (size_t)(32 * u.dil);
    constexpr int W = (MODE == 0) ? 128 : 64, TW = (MODE == 0) ? TABA_W : TABC_W, TC = (MODE == 0) ? 256 : 192;
    const int kk = tid >> 3, ch = tid & 7;
    const bf16_t* kg = P + (size_t)(u.rowbase + u.rho + u.dil * kk) * NP + u.kcol + ch * 8;
    const bf16_t* vg = P + (size_t)(u.rowbase + u.rho + u.dil * kk) * NP + u.vcol + ch * 8;
    const size_t tstep = (size_t)64 * u.dil * NP;
    u32x4 kreg = *(const u32x4*)(kg + (size_t)u.t_lo * tstep), vreg = *(const u32x4*)(vg + (size_t)u.t_lo * tstep);
    bf16x8 qa[4], qb[4];
#pragma unroll
    for (int ds = 0; ds < 4; ++ds) { qa[ds] = *(const bf16x8*)(P + qrow_a * NP + u.qcol + hq * 64 + ds * 16 + hi * 8); qb[ds] = *(const bf16x8*)(P + qrow_b * NP + u.qcol + hq * 64 + ds * 16 + hi * 8); }
    LAS unsigned char* kst = lds + kk * KP + ch * 16; LAS unsigned char* vst = lds + KBUF + kk * VP + ch * 16;
    *(LAS u32x4*)kst = kreg; *(LAS u32x4*)vst = vreg;
    asm volatile("" :: "v"(qa[0]), "v"(qa[1]), "v"(qa[2]), "v"(qa[3]), "v"(qb[0]), "v"(qb[1]), "v"(qb[2]), "v"(qb[3]));
    const LAS unsigned char* krd = lds + r32 * KP + hi * 16;
    const LAS unsigned char* vrd = lds + KBUF + (4 * hi + ((lane & 15) >> 2)) * VP + ((lane >> 4) & 1) * 32 + (lane & 3) * 8;
    const LAS float* btab = (const LAS float*)(lds + L_TAB) + u.tabidx + hq * TW + TC;
    float m_sink = -1e30f;
    if (MODE == 0) m_sink = p.sink[u.g * 12 + u.kvi * 4 + hq] * LOG2E;
    float ma = FAST ? 0.f : m_sink, mb = ma, la = 0.f, lb = 0.f;
    f32x16 oa0 = {}, oa1 = {}, ob0 = {}, ob1 = {};
    int wt_lo = u.t_lo, wt_hi = u.t_hi;
    if (MODE != 1) { const int c = (u.i0 >> 6) + sub; wt_lo = c - W / 64 > wt_lo ? c - W / 64 : wt_lo; wt_hi = c + W / 64 < wt_hi ? c + W / 64 : wt_hi; }
    tile_loop<MODE, false, FAST>(u, kg, vg, tstep, kreg, vreg, kst, vst, krd, vrd, btab, iqa, hi, wt_lo, wt_hi, qa, qb, ma, la, mb, lb, oa0, oa1, ob0, ob1);
    store_block<MODE>(p, u, oa0, oa1, ma, la, m_sink, qrow_a, hq, hi);
    store_block<MODE>(p, u, ob0, ob1, mb, lb, m_sink, qrow_b, hq, hi);
}

__device__ __forceinline__ void seqblk_decode(int sb, int& rowbase, int& S, int& blk) {
    if (sb < 256) { rowbase = MP + (sb >> 5) * 4096; S = 4096; blk = sb & 31; } else { sb -= 256; rowbase = (sb >> 4) * 2048; S = 2048; blk = sb & 15; }
}
__device__ __forceinline__ void phase(LAS unsigned char* lds, const Params& p, int layer, int cslot, int ubeg, int uend, int tid, int wave, int lane) {
    { const float* gt = (const float*)(p.ws + WS_TAB); LAS float* lt = (LAS float*)(lds + L_TAB);
      for (int i = tid; i < TABA_N + TABC_N; i += NTHREADS) lt[i] = gt[i]; }
    unsigned* ctr = (unsigned*)(p.ws + WS_CTL) + 64 * cslot;
    const bool fast = __builtin_amdgcn_readfirstlane(((const int*)(p.ws + WS_TAB))[TABA_N + TABC_N + ROPE_N + layer]) != 0;
    volatile LAS int* slot = (volatile LAS int*)(lds + L_SLOT);
    int nxt = 0;
    if (tid == 0) { nxt = ubeg + (int)atomicAdd(ctr, 1u); *slot = nxt; }
    __syncthreads();
    int un = *slot;
    while (un < uend) {
        if (tid == 0) nxt = ubeg + (int)atomicAdd(ctr, 1u);
        UnitP u; u.dil = 1; u.rho = 0; u.g = 0; u.kvi = 0; u.tabidx = 0; u.gcol = 0; u.ocol = 0;
        if (un < N_BS + N_BP) {
            int b, kvh, blk, S;
            if (un < N_BS) { b = un / 96; const int rem = un % 96; kvh = rem >> 5; blk = rem & 31; u.rowbase = MP + b * 4096; S = 4096; }
            else { const int v = un - N_BS; b = v / 48; const int rem = v % 48; kvh = rem >> 4; blk = rem & 15; u.rowbase = b * 2048; S = 2048; }
            u.i0 = blk * 128; u.t_lo = 0; u.t_hi = S / 64 - 1; u.qcol = C_QB + kvh * 256; u.kcol = C_KB + kvh * 64; u.vcol = C_VB + kvh * 64; u.gcol = C_GB + kvh * 256; u.ocol = 768 + kvh * 256;
            if (fast) unit<1, true>(lds, p, u, tid, wave, lane); else unit<1, false>(lds, p, u, tid, wave, lane);
        } else if (un < N_BS + N_BP + N_A) {
            const int v = un - (N_BS + N_BP), sb = v / 3, kvh = v % 3; int S, blk; seqblk_decode(sb, u.rowbase, S, blk);
            u.i0 = blk * 128; u.t_lo = 2 * blk - 2 < 0 ? 0 : 2 * blk - 2; u.t_hi = 2 * blk + 3 > S / 64 - 1 ? S / 64 - 1 : 2 * blk + 3;
            u.qcol = C_QA + kvh * 256; u.kcol = C_KA + kvh * 64; u.vcol = C_VA + kvh * 64; u.gcol = C_GA + kvh * 256; u.ocol = kvh * 256; u.tabidx = kvh * 4 * TABA_W; u.g = layer; u.kvi = kvh;
            if (fast) unit<0, true>(lds, p, u, tid, wave, lane); else unit<0, false>(lds, p, u, tid, wave, lane);
        } else {
            const int v = un - (N_BS + N_BP + N_A), g = v / 640, r = v % 640, sb = r >> 1, kvi = r & 1; int S, blk; seqblk_decode(sb, u.rowbase, S, blk);
            const int dsh = 2 * g, nb = (S >> dsh) >> 7;
            u.dil = 1 << dsh; u.rho = blk / nb; const int lb = blk % nb; u.i0 = lb * 128; u.t_lo = 2 * lb - 1 < 0 ? 0 : 2 * lb - 1; u.t_hi = 2 * lb + 2 > 2 * nb - 1 ? 2 * nb - 1 : 2 * lb + 2;
            u.qcol = C_QC + (g * 8 + kvi * 4) * 64; u.kcol = C_KC + (g * 2 + kvi) * 64; u.vcol = C_VC + (g * 2 + kvi) * 64; u.tabidx = TABA_N + (g * 8 + kvi * 4) * TABC_W; u.g = g; u.kvi = kvi;
            if (fast) unit<2, true>(lds, p, u, tid, wave, lane); else unit<2, false>(lds, p, u, tid, wave, lane);
        }
        __syncthreads();
        if (tid == 0) *slot = nxt;
        __syncthreads();
        un = *slot;
    }
}
__device__ __forceinline__ void combine_one(const bf16_t* cs, const float* lse, const bf16_t* P, bf16_t* mix, size_t i) {
    const size_t row = i >> 6; const int hc = (int)(i >> 3) & 7, chk = (int)i & 7;
    const float l0 = lse[row * 8 + hc], l1 = lse[((size_t)MT + row) * 8 + hc], l2 = lse[((size_t)2 * MT + row) * 8 + hc];
    const u32x4 a = *(const u32x4*)(cs + row * 512 + hc * 64 + chk * 8), b = *(const u32x4*)(cs + ((size_t)MT + row) * 512 + hc * 64 + chk * 8),
                c = *(const u32x4*)(cs + ((size_t)2 * MT + row) * 512 + hc * 64 + chk * 8), gt = *(const u32x4*)(P + row * NP + C_GC + hc * 64 + chk * 8);
    const float mx = fmaxf(l0, fmaxf(l1, l2));
    float w0 = __builtin_amdgcn_exp2f(l0 - mx), w1 = __builtin_amdgcn_exp2f(l1 - mx), w2 = __builtin_amdgcn_exp2f(l2 - mx);
    const float inv = 1.0f / (w0 + w1 + w2); w0 *= inv; w1 *= inv; w2 *= inv;
    u32x4 o;
#pragma unroll
    for (int k = 0; k < 4; ++k) {
        const float lo = (w0 * bf_lo(a[k]) + w1 * bf_lo(b[k]) + w2 * bf_lo(c[k])) * bf_lo(gt[k]), hi = (w0 * bf_hi(a[k]) + w1 * bf_hi(b[k]) + w2 * bf_hi(c[k])) * bf_hi(gt[k]);
        o[k] = pk_bf16(lo, hi);
    }
    *(u32x4*)(mix + row * DM + 1536 + hc * 64 + chk * 8) = o;
}
__device__ __forceinline__ void combine_phase(const Params& p, int tid) {
    const bf16_t* cs = (const bf16_t*)(p.ws + WS_CS); const float* lse = (const float*)(p.ws + WS_LSE);
    const bf16_t* P = (const bf16_t*)(p.ws + WS_P); bf16_t* mix = (bf16_t*)(p.ws + WS_H);
    const size_t stride = (size_t)gridDim.x * NTHREADS, total = (size_t)MT * 64;
    size_t i = (size_t)blockIdx.x * NTHREADS + tid;
    for (; i + 3 * stride < total; i += 4 * stride) { combine_one(cs, lse, P, mix, i); combine_one(cs, lse, P, mix, i + stride); combine_one(cs, lse, P, mix, i + 2 * stride); combine_one(cs, lse, P, mix, i + 3 * stride); }
    for (; i < total; i += stride) combine_one(cs, lse, P, mix, i);
}
}

typedef const __attribute__((address_space(4))) Params* KParamsPtr;
__device__ __forceinline__ Params fresh_params() {
#if defined(__HIP_DEVICE_COMPILE__)
    KParamsPtr pp = (KParamsPtr)__builtin_amdgcn_kernarg_segment_ptr(); asm volatile("" : "+s"(pp)); Params r;
    r.x_prompt = pp->x_prompt; r.x_sample = pp->x_sample; r.ln_g = pp->ln_g; r.w_in = pp->w_in; r.qna = pp->qna; r.kna = pp->kna; r.sink = pp->sink; r.qnb = pp->qnb; r.knb = pp->knb;
    r.qnc = pp->qnc; r.knc = pp->knc; r.rel_bias = pp->rel_bias; r.w_out = pp->w_out; r.out = pp->out; r.ws = pp->ws; return r;
#else
    return Params{};
#endif
}
#define PHASE_IDS() int tid_l = threadIdx.x; asm volatile("" : "+v"(tid_l)); const int tid = tid_l, lane = tid & 63, wave = __builtin_amdgcn_readfirstlane(tid >> 6); (void)lane; (void)wave
#define GRID_BAR() do { XcdBarrier b_; b_.bar = (unsigned*)(fresh_params().ws + WS_CTL) + CW_BAR; b_.x = xb_xcc_id(); b_.st = (volatile LAS unsigned*)(lds + XBAR_LDS); xcd_barrier(b_); } while (0)
__global__ void __launch_bounds__(NTHREADS, 2) fwd_megakernel(Params p_unused) {
    extern __shared__ __attribute__((aligned(16))) unsigned char lds_raw[];
    LAS unsigned char* lds = (LAS unsigned char*)lds_raw;
    if (threadIdx.x < 2) ((volatile LAS unsigned*)(lds + XBAR_LDS))[threadIdx.x] = 0u;
    __syncthreads();
    { const Params p = fresh_params(); (void)xcd_barrier_post((unsigned*)(p.ws + WS_CTL) + CW_BAR, (volatile LAS unsigned*)(lds + XBAR_LDS)); }
#ifndef NO_PRO
    { const Params p = fresh_params(); PHASE_IDS(); prologue_phase(p, lds, tid, wave, lane); }
#endif
#if defined(REP_SYNC)
    for (int i = 0; i < REP_SYNC; ++i) GRID_BAR();
#endif
    for (int layer = 0; layer < 2; ++layer) {
        asm volatile("" : "+s"(layer));
#ifndef NO_NORM
        { const Params p = fresh_params(); PHASE_IDS();
          const float* x0 = layer == 0 ? p.x_prompt : p.out; const float* x1 = layer == 0 ? p.x_sample : p.out + (size_t)MP * DM;
          norm_phase(x0, x1, p.ln_g + layer * DM, (bf16_t*)(p.ws + WS_H), wave, lane); }
#endif
        if (layer == 0) cg::this_grid().sync(); else GRID_BAR();
#if defined(NAIVE_G1)
        { const Params p = fresh_params(); PHASE_IDS(); naive_g1(p, layer, wave, lane); }
#endif
#if defined(NAIVE_G2X)
#endif
#ifndef NO_G1
        { const Params p = fresh_params();
          pg8::Gemm g{(const bf16_t*)(p.ws + WS_H), (const bf16_t*)(p.ws + WS_WIN) + (size_t)layer * NP * DM, MT, NP, DM}; pg8::StaticOrder S; S.init(MT, NP, (int)gridDim.x, (int)blockIdx.x);
          pg8::EpiProj E{(bf16_t*)(p.ws + WS_P), p.qna + layer * 64, p.kna + layer * 64, p.qnb + layer * 64, p.knb + layer * 64, p.qnc + layer * 64, p.knc + layer * 64, (const float*)(p.ws + WS_TAB) + TABA_N + TABC_N};
          pg8::gemm_phase<pg8::EpiProj, pg8::StaticOrder, true, true>(lds, g, S, E);
#if defined(REP_G1)
          pg8::gemm_phase<pg8::EpiProj, pg8::StaticOrder, true, true>(lds, g, S, E);
#endif
        }
#endif
        GRID_BAR();
#ifndef NO_ATT
        { const Params p = fresh_params(); PHASE_IDS(); att::phase(lds, p, layer, layer, 0, att::N_UNITS, tid, wave, lane); }
#if defined(REP_ATT)
        GRID_BAR();
        { const Params p = fresh_params(); PHASE_IDS(); att::phase(lds, p, layer, layer + 2, REP_ATT_LO, REP_ATT_HI, tid, wave, lane); }
#endif
#endif
        GRID_BAR();
#ifndef NO_CMB
        { const Params p = fresh_params(); PHASE_IDS(); att::combine_phase(p, tid); }
#endif
        GRID_BAR();
#if defined(NAIVE_MASK)
        { const Params p = fresh_params(); PHASE_IDS(); naive_attention(p, layer, wave, lane); }
        GRID_BAR();
#endif
#if defined(NAIVE_G2)
        { const Params p = fresh_params(); PHASE_IDS(); naive_g2(p, layer, wave, lane); }
#endif
#ifndef NO_G2
        { const Params p = fresh_params();
          const float* x0 = layer == 0 ? p.x_prompt : p.out; const float* x1 = layer == 0 ? p.x_sample : p.out + (size_t)MP * DM;
          pg8::Gemm g{(const bf16_t*)(p.ws + WS_H), (const bf16_t*)(p.ws + WS_WOUT) + (size_t)layer * DM * DM, MT, DM, DM}; pg8::StaticOrder S; S.init(MT, DM, (int)gridDim.x, (int)blockIdx.x);
          pg8::EpiRes E{x0, x1, p.out};
          pg8::gemm_phase<pg8::EpiRes, pg8::StaticOrder, true, true>(lds, g, S, E); }
#endif
        if (layer == 0) GRID_BAR();
    }
}

extern "C" void kernel_launch(void* const* d_in, const int* in_sizes, int n_in, void* d_out, int out_size, void* d_ws, size_t ws_size, hipStream_t stream) {
    static int grid_blocks = 0;
    if (grid_blocks == 0) {
        if (n_in != 13 || out_size != MT * DM || ws_size < WS_END) { fprintf(stderr, "kernel_launch: unexpected shapes (n_in %d, out %d, ws %zu < %zu)\n", n_in, out_size, ws_size, (size_t)WS_END); grid_blocks = -1; return; }
        int dev = 0, cus = 0, per_cu = 0;
        hipGetDevice(&dev); hipDeviceGetAttribute(&cus, hipDeviceAttributeMultiprocessorCount, dev);
        hipFuncSetAttribute((const void*)fwd_megakernel, hipFuncAttributeMaxDynamicSharedMemorySize, LDS_BYTES);
        hipOccupancyMaxActiveBlocksPerMultiprocessor(&per_cu, (const void*)fwd_megakernel, NTHREADS, LDS_BYTES);
        if (per_cu < 1) { fprintf(stderr, "kernel_launch: occupancy query says %d blocks/CU\n", per_cu); per_cu = 1; }
        (void)hipGetLastError();
        grid_blocks = cus * 1;
    }
    if (grid_blocks < 0) return;
    hipMemsetAsync((char*)d_ws + WS_CTL, 0, CTL_BYTES, stream);
    Params p{};
    p.x_prompt = (const float*)d_in[0]; p.x_sample = (const float*)d_in[1]; p.ln_g = (const float*)d_in[2]; p.w_in = (const float*)d_in[3]; p.qna = (const float*)d_in[4]; p.kna = (const float*)d_in[5];
    p.sink = (const float*)d_in[6]; p.qnb = (const float*)d_in[7]; p.knb = (const float*)d_in[8]; p.qnc = (const float*)d_in[9]; p.knc = (const float*)d_in[10]; p.rel_bias = (const float*)d_in[11];
    p.w_out = (const float*)d_in[12]; p.out = (float*)d_out; p.ws = (unsigned char*)d_ws;
    void* args[] = {&p};
    hipError_t e = hipLaunchCooperativeKernel((const void*)fwd_megakernel, dim3(grid_blocks), dim3(NTHREADS), args, LDS_BYTES, stream);
    if (e != hipSuccess) fprintf(stderr, "cooperative launch failed: %s (grid %d)\n", hipGetErrorString(e), grid_blocks);
}
```

```cpp
#include <hip/hip_runtime.h>
#include <hip/hip_cooperative_groups.h>
#include <cstdio>
#include <cstdint>
namespace cg = cooperative_groups;

constexpr int DM = 2048, NP = 6656, MP = 8192, MS = 32768, MT = MP + MS;
constexpr int C_QA = 0, C_KA = 768, C_VA = 960, C_GA = 1152, C_QB = 1920, C_KB = 2688, C_VB = 2880, C_GB = 3072, C_QC = 3840, C_KC = 5376, C_VC = 5760, C_GC = 6144;
constexpr float QSCALE = 0.125f * 1.4426950408889634f;
constexpr float LOG2E = 1.4426950408889634f;
constexpr float RMS_EPS = 1e-6f;

namespace pg8 {
#define PG8_LAS __attribute__((address_space(3)))
typedef unsigned short bf16_t;
typedef short bf16x8 __attribute__((ext_vector_type(8)));
typedef float f32x4 __attribute__((ext_vector_type(4)));
typedef unsigned u32x4 __attribute__((ext_vector_type(4)));
constexpr int BM = 256, BK = 64, HALF = 128, HTB = HALF * BK * 2  , STAGE_BYTES = 8 * HTB, NXCD = 8, WGM = 8;

__host__ __device__ __forceinline__ int lds_byte(int r, int c) { const int st = (r >> 4) * 2 + (c >> 5), rr = r & 15, cc = c & 31, ob = rr * 64 + cc * 2; return st * 1024 + (ob ^ (((ob >> 9) & 1) << 5)); }
__host__ __device__ __forceinline__ void stage_rc(int b, int& R, int& C) { const int st = b / 1024, sb = b % 1024, swz = sb ^ (((sb >> 9) & 1) << 5); R = (st >> 1) * 16 + swz / 64; C = (st & 1) * 32 + (swz % 64) / 2; }
__host__ __device__ __forceinline__ int perm32(int rho) { const int n = rho >> 4, i = rho & 15; return 8 * (i >> 2) + 4 * n + (i & 3); }

struct Unit { int pm, pn; };
struct Gemm { const bf16_t* A; const bf16_t* Bt; int M, N, K; };

struct StaticOrder {
    int nM, nN, nwg, G, c;
    __host__ __device__ void init(int M, int N, int G_, int c_) { nM = M / BM; nN = N / BM; nwg = nM * nN; G = G_; c = c_; }
    __host__ __device__ bool next(int i, Unit& u) const {
        const long L = (long)i * G + c; if (L >= nwg) return false;
        int wgid = (int)L; { const int q = nwg / NXCD, r = nwg % NXCD, xcd = wgid % NXCD, off = wgid / NXCD; wgid = (xcd < r ? xcd * (q + 1) : r * (q + 1) + (xcd - r) * q) + off; }
        const int nig = WGM * nN, gid = wgid / nig, fm = gid * WGM, gsz = (nM - fm) < WGM ? (nM - fm) : WGM;
        u.pm = fm + ((wgid % nig) % gsz); u.pn = (wgid % nig) / gsz; return true;
    }
    __device__ __forceinline__ void a_ready(const Unit&) const {}
    __device__ __forceinline__ void done(const Unit&) const {}
};

__device__ __forceinline__ unsigned cvt_pk_bf16(float lo, float hi) { unsigned r; asm volatile("v_cvt_pk_bf16_f32 %0, %1, %2" : "=v"(r) : "v"(lo), "v"(hi)); return r; }
typedef float f32x2e __attribute__((ext_vector_type(2)));
struct EpiProj {
    static constexpr bool PERM = true, AFTER_DRAIN = false;
    bf16_t* P; const float *qna, *kna, *qnb, *knb, *qnc, *knc; const float* rope;
    const float* rowss;
    __device__ __forceinline__ float rrow(int row) const { return rowss ? __builtin_amdgcn_rsqf(rowss[row] * (1.0f / DM) + RMS_EPS) : 1.0f; }
    __device__ __forceinline__ void operator()(const f32x4 (&acc)[2][2][4][2], const Unit& u, int wr, int wc, int fr, int fq) const {
        const int hd = u.pn * 4 + wc;
        int type; const float* w = qna; float qs = 1.f;
        if (hd < 12) { type = 2; w = qna; qs = QSCALE; } else if (hd < 15) { type = 2; w = kna; } else if (hd < 18) { type = 0; } else if (hd < 30) { type = 1; }
        else if (hd < 42) { type = 3; w = qnb; qs = QSCALE; } else if (hd < 45) { type = 3; w = knb; } else if (hd < 48) { type = 0; } else if (hd < 60) { type = 1; }
        else if (hd < 84) { type = 2; w = qnc; qs = QSCALE; } else if (hd < 90) { type = 2; w = knc; } else if (hd < 96) { type = 0; } else { type = 1; }
        const int row0 = u.pm * BM + wr * 64 + fr;
        bf16_t* base = P + (size_t)row0 * NP + hd * 64 + 8 * fq;
        if (type == 0) {
#pragma unroll
            for (int ai = 0; ai < 2; ++ai)
#pragma unroll
                for (int m = 0; m < 4; ++m) { bf16_t* rowp = base + (size_t)(ai * HALF + m * 16) * NP; const float rr = rrow(row0 + ai * HALF + m * 16);
#pragma unroll
                    for (int bj = 0; bj < 2; ++bj) { const f32x4 v0 = acc[ai][bj][m][0] * rr, v1 = acc[ai][bj][m][1] * rr; u32x4 o;
                        o.x = cvt_pk_bf16(v0[0], v0[1]); o.y = cvt_pk_bf16(v0[2], v0[3]); o.z = cvt_pk_bf16(v1[0], v1[1]); o.w = cvt_pk_bf16(v1[2], v1[3]);
                        *(u32x4*)(rowp + bj * 32) = o; } }
        } else if (type == 1) {
#pragma unroll
            for (int ai = 0; ai < 2; ++ai)
#pragma unroll
                for (int m = 0; m < 4; ++m) { bf16_t* rowp = base + (size_t)(ai * HALF + m * 16) * NP; const float rr = rrow(row0 + ai * HALF + m * 16);
#pragma unroll
                    for (int bj = 0; bj < 2; ++bj) { f32x4 v[2] = {acc[ai][bj][m][0] * rr, acc[ai][bj][m][1] * rr};
#pragma unroll
                        for (int n = 0; n < 2; ++n)
#pragma unroll
                            for (int e = 0; e < 4; ++e) { const float g = v[n][e]; v[n][e] = g * __builtin_amdgcn_rcpf(1.f + __builtin_amdgcn_exp2f(-g * LOG2E)); }
                        u32x4 o; o.x = cvt_pk_bf16(v[0][0], v[0][1]); o.y = cvt_pk_bf16(v[0][2], v[0][3]); o.z = cvt_pk_bf16(v[1][0], v[1][1]); o.w = cvt_pk_bf16(v[1][2], v[1][3]);
                        *(u32x4*)(rowp + bj * 32) = o; } }
        } else {
            f32x4 wv[2][2];
#pragma unroll
            for (int bj = 0; bj < 2; ++bj)
#pragma unroll
                for (int n = 0; n < 2; ++n) wv[bj][n] = *(const f32x4*)(w + 32 * bj + 8 * fq + 4 * n);
            const float sgn = (fq < 2) ? -1.f : 1.f;
#pragma unroll
            for (int ai = 0; ai < 2; ++ai)
#pragma unroll
                for (int m = 0; m < 4; ++m) { bf16_t* rowp = base + (size_t)(ai * HALF + m * 16) * NP; const float rr = rrow(row0 + ai * HALF + m * 16);
                    f32x4 v[2][2]; float ss = 0.f;
#pragma unroll
                    for (int bj = 0; bj < 2; ++bj)
#pragma unroll
                        for (int n = 0; n < 2; ++n) { v[bj][n] = acc[ai][bj][m][n] * rr; const f32x4 x = v[bj][n]; ss += (x[0] * x[0] + x[1] * x[1]) + (x[2] * x[2] + x[3] * x[3]); }
                    ss += __shfl_xor(ss, 16); ss += __shfl_xor(ss, 32);
                    const float rs = __builtin_amdgcn_rsqf(ss * (1.0f / 64.0f) + RMS_EPS);
#pragma unroll
                    for (int bj = 0; bj < 2; ++bj)
#pragma unroll
                        for (int n = 0; n < 2; ++n) v[bj][n] = v[bj][n] * rs * wv[bj][n];
                    if (type == 3) {
                        const int r = row0 + ai * HALF + m * 16, t = r & ((r < MP) ? 2047 : 4095);
#pragma unroll
                        for (int bj = 0; bj < 2; ++bj) { const int pos = bj ? (t & 63) : (t >> 6);
#pragma unroll
                            for (int n = 0; n < 2; ++n) { const float* tp = rope + (size_t)(pos * 16 + 8 * (fq & 1) + 4 * n) * 2;
                                const f32x4 cs0 = *(const f32x4*)tp, cs1 = *(const f32x4*)(tp + 4); const f32x4 x = v[bj][n]; f32x4 pr;
                                pr[0] = __shfl_xor(x[0], 32); pr[1] = __shfl_xor(x[1], 32); pr[2] = __shfl_xor(x[2], 32); pr[3] = __shfl_xor(x[3], 32);
                                f32x4 y; y[0] = x[0] * cs0[0] + sgn * pr[0] * cs0[1]; y[1] = x[1] * cs0[2] + sgn * pr[1] * cs0[3];
                                y[2] = x[2] * cs1[0] + sgn * pr[2] * cs1[1]; y[3] = x[3] * cs1[2] + sgn * pr[3] * cs1[3]; v[bj][n] = y; } }
                    }
#pragma unroll
                    for (int bj = 0; bj < 2; ++bj) { const f32x4 v0 = v[bj][0] * qs, v1 = v[bj][1] * qs; u32x4 o;
                        o.x = cvt_pk_bf16(v0[0], v0[1]); o.y = cvt_pk_bf16(v0[2], v0[3]); o.z = cvt_pk_bf16(v1[0], v1[1]); o.w = cvt_pk_bf16(v1[2], v1[3]);
                        *(u32x4*)(rowp + bj * 32) = o; } }
        }
    }
};
struct EpiRes {
    static constexpr bool PERM = true, AFTER_DRAIN = false;
    const float* x0; const float* x1; float* out;
    bf16_t* hq; const float* g2; float* rowss;
    __device__ __forceinline__ void operator()(const f32x4 (&acc)[2][2][4][2], const Unit& u, int wr, int wc, int fr, int fq) const {
        const int row0 = u.pm * BM + wr * 64 + fr, col0 = u.pn * BM + wc * 32 + 8 * fq;
        const float* xb = (row0 < MP) ? x0 + (size_t)row0 * DM : x1 + (size_t)(row0 - MP) * DM;
        float* ob = out + (size_t)row0 * DM;
#pragma unroll
        for (int ai = 0; ai < 2; ++ai)
#pragma unroll
            for (int m = 0; m < 4; ++m) { const size_t off = (size_t)(ai * HALF + m * 16) * DM + col0; float ss = 0.f;
#pragma unroll
                for (int bj = 0; bj < 2; ++bj) { const f32x4 a0 = *(const f32x4*)(xb + off + bj * HALF), a1 = *(const f32x4*)(xb + off + bj * HALF + 4);
                    const f32x4 o0 = a0 + acc[ai][bj][m][0], o1 = a1 + acc[ai][bj][m][1];
                    *(f32x4*)(ob + off + bj * HALF) = o0; *(f32x4*)(ob + off + bj * HALF + 4) = o1;
                    if (hq) { const f32x4 g0 = *(const f32x4*)(g2 + col0 + bj * HALF), g1 = *(const f32x4*)(g2 + col0 + bj * HALF + 4); u32x4 w;
                        w.x = cvt_pk_bf16(o0[0] * g0[0], o0[1] * g0[1]); w.y = cvt_pk_bf16(o0[2] * g0[2], o0[3] * g0[3]); w.z = cvt_pk_bf16(o1[0] * g1[0], o1[1] * g1[1]); w.w = cvt_pk_bf16(o1[2] * g1[2], o1[3] * g1[3]);
                        *(u32x4*)(hq + (size_t)row0 * DM + off + bj * HALF) = w;
                        ss += (o0[0] * o0[0] + o0[1] * o0[1]) + (o0[2] * o0[2] + o0[3] * o0[3]) + (o1[0] * o1[0] + o1[1] * o1[1]) + (o1[2] * o1[2] + o1[3] * o1[3]); } }
                if (hq) { ss += __shfl_xor(ss, 16); ss += __shfl_xor(ss, 32); if (fq == 0) atomicAdd(rowss + row0 + ai * HALF + m * 16, ss); } }
    }
};

template <class Epi, class Sched, bool ALIGN_EPI = false, bool SP2 = false>
__device__ __forceinline__ void gemm_phase(PG8_LAS unsigned char* lds, const Gemm g, const Sched& S, const Epi& E) {
    int tid_l = threadIdx.x; asm volatile("" : "+v"(tid_l));
    const int tid = tid_l, wid = __builtin_amdgcn_readfirstlane(tid >> 6), lane = tid & 63, wr = wid >> 2, wc = wid & 3, fr = lane & 15, fq = lane >> 4;
    const int K = g.K, nt = K / BK;
    unsigned voffA[2], voffB[2];
#pragma unroll
    for (int i = 0; i < 2; ++i) { int R, C; stage_rc(tid * 16 + i * 8192, R, C); const int Rb = Epi::PERM ? ((R & ~31) + perm32(R & 31)) : R;
        voffA[i] = (unsigned)(R * K + C) * 2u; voffB[i] = (unsigned)(Rb * K + C) * 2u; }
    const size_t kstep = (size_t)(BK * 2);
    const size_t hstep = (size_t)HALF * K * 2;
    const size_t tstep = 2 * hstep;
    const unsigned ldsw = (unsigned)wid * 1024u;
    const int aoff = lds_byte(wr * 64 + fr, fq * 8), boff = lds_byte(wc * 32 + fr, fq * 8);
#define PG8_SA(b, h) (((b) * 2 + (h)) * HTB)
#define PG8_SB(b, h) ((4 + (b) * 2 + (h)) * HTB)
#define PG8_STAGE(bufoff, gbase, voff) do { _Pragma("unroll") for (int _i = 0; _i < 2; ++_i) \
        __builtin_amdgcn_global_load_lds((const unsigned*)((const char*)(gbase) + (voff)[_i]), (PG8_LAS unsigned*)(lds + (bufoff) + ldsw + _i * 8192), 16, 0, 0); } while (0)
#define PG8_LDA(dst, b, h) do { _Pragma("unroll") for (int m = 0; m < 4; ++m) _Pragma("unroll") for (int k = 0; k < 2; ++k) dst[m][k] = *(const PG8_LAS bf16x8*)(lds + PG8_SA(b, h) + aoff + m * 2048 + k * 1024); } while (0)
#define PG8_LDB(dst, b, h) do { _Pragma("unroll") for (int n = 0; n < 2; ++n) _Pragma("unroll") for (int k = 0; k < 2; ++k) dst[n][k] = *(const PG8_LAS bf16x8*)(lds + PG8_SB(b, h) + boff + n * 2048 + k * 1024); } while (0)
#define PG8_MMA(ai, bj, At, Bt) do { __builtin_amdgcn_s_setprio(1); _Pragma("unroll") for (int m = 0; m < 4; ++m) _Pragma("unroll") for (int n = 0; n < 2; ++n) _Pragma("unroll") for (int k = 0; k < 2; ++k) \
        acc[ai][bj][m][n] = __builtin_amdgcn_mfma_f32_16x16x32_bf16(Bt[n][k], At[m][k], acc[ai][bj][m][n], 0, 0, 0); __builtin_amdgcn_s_setprio(0); } while (0)
#define PG8_WAIT_V(n) asm volatile("s_waitcnt vmcnt(" #n ")" ::: "memory")
#define PG8_WAIT_L(n) asm volatile("s_waitcnt lgkmcnt(" #n ")" ::: "memory")
#define PG8_BAR __builtin_amdgcn_s_barrier()
#define PG8_SCHED __builtin_amdgcn_sched_barrier(0)
    Unit cur, nxt; int ui = 0;
    if (!S.next(0, cur)) return;
    f32x4 acc[2][2][4][2];
#pragma unroll
    for (int a = 0; a < 2; ++a)
#pragma unroll
        for (int b = 0; b < 2; ++b)
#pragma unroll
            for (int m = 0; m < 4; ++m)
#pragma unroll
                for (int n = 0; n < 2; ++n) acc[a][b][m][n] = (f32x4){0.f, 0.f, 0.f, 0.f};
    bf16x8 At[4][2], B0[2][2], B1[2][2];
    const char* cA = (const char*)g.A + (size_t)cur.pm * tstep; const char* cB = (const char*)g.Bt + (size_t)cur.pn * tstep;
    S.a_ready(cur);
    if constexpr (SP2) {
        PG8_STAGE(PG8_SB(0, 0), cB, voffB); PG8_STAGE(PG8_SB(0, 1), cB + hstep, voffB); PG8_STAGE(PG8_SA(0, 0), cA, voffA); PG8_STAGE(PG8_SA(0, 1), cA + hstep, voffA);
        if (wr == 1) PG8_BAR;
        PG8_WAIT_V(2); PG8_BAR;
        PG8_STAGE(PG8_SB(1, 0), cB + kstep, voffB); PG8_STAGE(PG8_SA(1, 0), cA + kstep, voffA); PG8_STAGE(PG8_SB(1, 1), cB + hstep + kstep, voffB);
        PG8_WAIT_V(6); PG8_BAR;
    } else {
        PG8_STAGE(PG8_SB(0, 0), cB, voffB); PG8_STAGE(PG8_SA(0, 0), cA, voffA); PG8_STAGE(PG8_SB(0, 1), cB + hstep, voffB); PG8_STAGE(PG8_SA(0, 1), cA + hstep, voffA);
        if (wr == 1) PG8_BAR;
        PG8_WAIT_V(4); PG8_BAR;
        PG8_STAGE(PG8_SB(1, 0), cB + kstep, voffB); PG8_STAGE(PG8_SA(1, 0), cA + kstep, voffA); PG8_STAGE(PG8_SB(1, 1), cB + hstep + kstep, voffB);
        PG8_WAIT_V(6); PG8_BAR;
    }
    for (;;) {
        const bool has_next = S.next(ui + 1, nxt);
        const char* nA = has_next ? (const char*)g.A + (size_t)nxt.pm * tstep : cA; const char* nB = has_next ? (const char*)g.Bt + (size_t)nxt.pn * tstep : cB;
        for (int t = 0; t < nt; t += 2) {
            const bool last = (t == nt - 2);
            const char* a1 = cA + (size_t)(t + 1) * kstep;
            const char* a2 = last ? nA : cA + (size_t)(t + 2) * kstep; const char* b2 = last ? nB : cB + (size_t)(t + 2) * kstep;
            const char* a3 = a2 + kstep; const char* b3 = b2 + kstep;
            if (last && has_next) S.a_ready(nxt);
            if constexpr (SP2) {
            PG8_LDB(B0, 0, 0); PG8_LDB(B1, 0, 1); PG8_SCHED; PG8_LDA(At, 0, 0); PG8_STAGE(PG8_SA(1, 1), a1 + hstep, voffA);
            PG8_WAIT_V(8); PG8_WAIT_L(0); PG8_BAR; PG8_MMA(0, 0, At, B0); PG8_MMA(0, 1, At, B1); PG8_BAR; PG8_SCHED;
            PG8_LDA(At, 0, 1); PG8_STAGE(PG8_SB(0, 0), b2, voffB); PG8_STAGE(PG8_SB(0, 1), b2 + hstep, voffB); PG8_STAGE(PG8_SA(0, 0), a2, voffA);
            PG8_WAIT_V(8); PG8_WAIT_L(0); PG8_BAR; PG8_MMA(1, 0, At, B0); PG8_MMA(1, 1, At, B1); PG8_BAR; PG8_SCHED;
            PG8_LDB(B0, 1, 0); PG8_LDB(B1, 1, 1); PG8_SCHED; PG8_LDA(At, 1, 0); PG8_STAGE(PG8_SA(0, 1), a2 + hstep, voffA);
            PG8_WAIT_V(8); PG8_WAIT_L(0); PG8_BAR; PG8_MMA(0, 0, At, B0); PG8_MMA(0, 1, At, B1); PG8_BAR; PG8_SCHED;
            PG8_LDA(At, 1, 1); PG8_STAGE(PG8_SB(1, 0), b3, voffB); PG8_STAGE(PG8_SB(1, 1), b3 + hstep, voffB); PG8_STAGE(PG8_SA(1, 0), a3, voffA);
            PG8_WAIT_V(8); PG8_WAIT_L(0); PG8_BAR; PG8_MMA(1, 0, At, B0); PG8_MMA(1, 1, At, B1); PG8_BAR; PG8_SCHED;
            } else {
            PG8_LDB(B0, 0, 0); PG8_SCHED; PG8_LDA(At, 0, 0); PG8_STAGE(PG8_SA(1, 1), a1 + hstep, voffA);
            PG8_WAIT_L(8); PG8_BAR; PG8_WAIT_L(0); PG8_MMA(0, 0, At, B0); PG8_BAR; PG8_SCHED;
            PG8_LDB(B1, 0, 1); PG8_STAGE(PG8_SB(0, 0), b2, voffB);
            PG8_BAR; PG8_WAIT_L(0); PG8_MMA(0, 1, At, B1); PG8_BAR;
            PG8_LDA(At, 0, 1); PG8_STAGE(PG8_SA(0, 0), a2, voffA);
            PG8_BAR; PG8_WAIT_L(0); PG8_MMA(1, 0, At, B0); PG8_BAR; PG8_SCHED;
            PG8_STAGE(PG8_SB(0, 1), b2 + hstep, voffB);
            PG8_WAIT_V(6); PG8_BAR; PG8_MMA(1, 1, At, B1); PG8_BAR;
            PG8_LDB(B0, 1, 0); PG8_SCHED; PG8_LDA(At, 1, 0); PG8_STAGE(PG8_SA(0, 1), a2 + hstep, voffA);
            PG8_WAIT_L(8); PG8_BAR; PG8_WAIT_L(0); PG8_MMA(0, 0, At, B0); PG8_BAR; PG8_SCHED;
            PG8_LDB(B1, 1, 1); PG8_STAGE(PG8_SB(1, 0), b3, voffB);
            PG8_BAR; PG8_WAIT_L(0); PG8_MMA(0, 1, At, B1); PG8_BAR;
            PG8_LDA(At, 1, 1); PG8_STAGE(PG8_SA(1, 0), a3, voffA);
            PG8_BAR; PG8_WAIT_L(0); PG8_MMA(1, 0, At, B0); PG8_BAR; PG8_SCHED;
            PG8_STAGE(PG8_SB(1, 1), b3 + hstep, voffB);
            PG8_WAIT_V(6); PG8_BAR; PG8_MMA(1, 1, At, B1); PG8_BAR;
            }
        }
        if constexpr (ALIGN_EPI) { if (wr == 0) PG8_BAR; }
        if constexpr (!Epi::AFTER_DRAIN) { E(acc, cur, wr, wc, fr, fq); S.done(cur); }
        if (!has_next) break;
#pragma unroll
        for (int a = 0; a < 2; ++a)
#pragma unroll
            for (int b = 0; b < 2; ++b)
#pragma unroll
                for (int m = 0; m < 4; ++m)
#pragma unroll
                    for (int n = 0; n < 2; ++n) acc[a][b][m][n] = (f32x4){0.f, 0.f, 0.f, 0.f};
        cur = nxt; cA = nA; cB = nB; ++ui;
        if constexpr (ALIGN_EPI) { if (wr == 1) PG8_BAR; }
    }
    PG8_WAIT_V(0);
    if constexpr (!ALIGN_EPI) { if (wr == 0) PG8_BAR; }
    PG8_BAR;
    if constexpr (Epi::AFTER_DRAIN) { E.fused(acc, cur, wr, wc, fr, fq, lds, wid, lane); S.done(cur); }
#undef PG8_SA
#undef PG8_SB
#undef PG8_STAGE
#undef PG8_LDA
#undef PG8_LDB
#undef PG8_MMA
#undef PG8_WAIT_V
#undef PG8_WAIT_L
#undef PG8_BAR
#undef PG8_SCHED
}
}

#define LAS __attribute__((address_space(3)))
typedef unsigned short bf16_t;
typedef short bf16x8 __attribute__((ext_vector_type(8)));
typedef short s16x4 __attribute__((ext_vector_type(4)));
typedef float f32x4 __attribute__((ext_vector_type(4)));
typedef float f32x16 __attribute__((ext_vector_type(16)));
typedef unsigned u32x4 __attribute__((ext_vector_type(4)));
typedef unsigned u32x2 __attribute__((ext_vector_type(2)));
constexpr int NWAVES = 8, NTHREADS = 512;
constexpr int LDS_BYTES = 139264;
__device__ __forceinline__ unsigned pk_bf16(float lo, float hi) { unsigned r; asm volatile("v_cvt_pk_bf16_f32 %0, %1, %2" : "=v"(r) : "v"(lo), "v"(hi)); return r; }
__device__ __forceinline__ float bf_lo(unsigned w) { return __uint_as_float(w << 16); }
__device__ __forceinline__ float bf_hi(unsigned w) { return __uint_as_float(w & 0xffff0000u); }

constexpr size_t WS_CTL = 0, CTL_BYTES = 32768;
constexpr int CW_BAR = 4096, XBAR_LDS = 131072 + 512;
constexpr size_t WS_TAB = 65536;
constexpr int TABA_W = 513, TABC_W = 385, TABA_N = 12 * TABA_W, TABC_N = 24 * TABC_W, ROPE_N = 64 * 16 * 2;
constexpr size_t WS_WIN = 1u << 20;
constexpr size_t WS_WOUT = WS_WIN + (size_t)2 * NP * DM * 2;
constexpr size_t WS_H = WS_WOUT + (size_t)2 * DM * DM * 2;
constexpr size_t WS_P = WS_H + (size_t)MT * DM * 2;
constexpr size_t WS_LSE = WS_P + (size_t)MT * NP * 2;
constexpr size_t WS_HQ = WS_LSE + (size_t)3 * MT * 8 * 4;
constexpr size_t WS_ROWSS = 262144;
constexpr size_t WS_END = WS_HQ + (size_t)MT * DM * 2;

__constant__ float INVF[16] = {1.0f, 0.5623413251903491f, 0.31622776601683794f, 0.1778279410038923f, 0.1f, 0.05623413251903491f, 0.03162277660168379f, 0.01778279410038923f,
                               0.01f, 0.005623413251903491f, 0.0031622776601683794f, 0.0017782794100389228f, 0.001f, 0.0005623413251903491f, 0.00031622776601683794f, 0.00017782794100389227f};

struct Params {
    const float* x_prompt; const float* x_sample; const float* ln_g; const float* w_in; const float* qna; const float* kna; const float* sink; const float* qnb; const float* knb;
    const float* qnc; const float* knc; const float* rel_bias; const float* w_out; float* out; unsigned char* ws;
};

__device__ __forceinline__ int t5_bucket(int rel) {
    const int n = rel < 0 ? -rel : rel;
    const int large = 8 + (n >= 15) + (n >= 27) + (n >= 50) + (n >= 91) + (n >= 166) + (n >= 305) + (n >= 559);
    return (rel > 0 ? 16 : 0) + (n < 8 ? n : large);
}
template <bool PERMUTE>
__device__ __forceinline__ void transpose_item(const float* W, int K, int N, bf16_t* WT, LAS float* scr, int item, int lane) {
    const int nblk = N / 32, kb = item / nblk, nb = item % nblk, k0 = 64 * kb, n0 = 32 * nb;
    float wv[32];
#pragma unroll
    for (int i = 0; i < 32; ++i) wv[i] = W[(size_t)(k0 + 2 * i + (lane >> 5)) * N + n0 + (lane & 31)];
#pragma unroll
    for (int i = 0; i < 32; ++i) scr[(2 * i + (lane >> 5)) * 33 + (lane & 31)] = wv[i];
    asm volatile("s_waitcnt lgkmcnt(0)" ::: "memory");
    const int c = lane & 7;
    const int r0 = PERMUTE ? (256 * (n0 >> 8) + 128 * ((n0 >> 5) & 1) + 32 * ((n0 >> 6) & 3)) : n0;
#pragma unroll
    for (int j = 0; j < 4; ++j) { const int n = (lane >> 3) + 8 * j; const LAS float* s = scr + (8 * c) * 33 + n;
        u32x4 o; o.x = pk_bf16(s[0 * 33], s[1 * 33]); o.y = pk_bf16(s[2 * 33], s[3 * 33]); o.z = pk_bf16(s[4 * 33], s[5 * 33]); o.w = pk_bf16(s[6 * 33], s[7 * 33]);
        *(u32x4*)(WT + (size_t)(r0 + n) * K + k0 + 8 * c) = o; }
    asm volatile("s_waitcnt lgkmcnt(0)" ::: "memory");
}
__device__ __forceinline__ void prologue_phase(const Params& p, LAS unsigned char* lds, int tid, int wave, int lane) {
    LAS float* scr = (LAS float*)(lds + wave * 16384);
    const int gw = blockIdx.x * NWAVES + wave, NGW = gridDim.x * NWAVES;
    constexpr int I_IN = (DM / 64) * (NP / 32), I_OUT = (DM / 64) * (DM / 32);
    bf16_t* win = (bf16_t*)(p.ws + WS_WIN); bf16_t* wout = (bf16_t*)(p.ws + WS_WOUT);
    for (int it = gw; it < 2 * (I_IN + I_OUT); it += NGW) {
        int r = it;
        if (r < 2 * I_IN) { const int l = r / I_IN; r -= l * I_IN; transpose_item<true>(p.w_in + (size_t)l * DM * NP, DM, NP, win + (size_t)l * NP * DM, scr, r, lane); }
        else { r -= 2 * I_IN; const int l = r / I_OUT; r -= l * I_OUT; transpose_item<false>(p.w_out + (size_t)l * DM * DM, DM, DM, wout + (size_t)l * DM * DM, scr, r, lane); }
    }
    float* tab = (float*)(p.ws + WS_TAB);
    { float* rs = (float*)(p.ws + WS_ROWSS); for (int i = blockIdx.x * NTHREADS + tid; i < MT; i += gridDim.x * NTHREADS) rs[i] = 0.f; }
    if (blockIdx.x == 0 && tid < 2) {
        const int l = tid; float mb = 0.f, ms = 0.f;
        for (int i = 0; i < 32 * 36; ++i) mb = fmaxf(mb, fabsf(p.rel_bias[i]));
        for (int i = 0; i < 12; ++i) ms = fmaxf(ms, fabsf(p.sink[l * 12 + i]));
        float qa = 0.f, ka = 0.f, qb = 0.f, kb = 0.f, qc = 0.f, kc = 0.f;
        for (int i = 0; i < 64; ++i) { qa = fmaxf(qa, fabsf(p.qna[l * 64 + i])); ka = fmaxf(ka, fabsf(p.kna[l * 64 + i])); qb = fmaxf(qb, fabsf(p.qnb[l * 64 + i]));
            kb = fmaxf(kb, fabsf(p.knb[l * 64 + i])); qc = fmaxf(qc, fabsf(p.qnc[l * 64 + i])); kc = fmaxf(kc, fabsf(p.knc[l * 64 + i])); }
        const float c = 64.f * QSCALE * 1.02f;
        const bool ok = (mb * LOG2E <= 8.f) && (ms * LOG2E <= 60.f) && (c * qa * ka <= 52.f) && (c * qb * kb <= 52.f) && (c * qc * kc <= 52.f);
        ((int*)tab)[TABA_N + TABC_N + ROPE_N + l] = ok ? 1 : 0;
    }
    for (int i = blockIdx.x * NTHREADS + tid; i < TABA_N + TABC_N + ROPE_N / 2; i += gridDim.x * NTHREADS) {
        if (i < TABA_N) { const int h = i / TABA_W, rel = i % TABA_W - 256; tab[i] = (rel >= -128 && rel <= 128) ? p.rel_bias[t5_bucket(rel) * 36 + h] * LOG2E : -INFINITY; }
        else if (i < TABA_N + TABC_N) { const int j = i - TABA_N, gh = j / TABC_W, rel = j % TABC_W - 192, g = gh >> 3; const int dil = (g == 0) ? 1 : (g == 1 ? 4 : 16);
            tab[i] = (rel >= -64 && rel <= 64) ? p.rel_bias[t5_bucket(rel * dil) * 36 + 12 + gh] * LOG2E : -INFINITY; }
        else { const int j = i - TABA_N - TABC_N, pos = j >> 4, f = j & 15; const float ang = (float)pos * INVF[f];
            tab[TABA_N + TABC_N + 2 * j] = cosf(ang); tab[TABA_N + TABC_N + 2 * j + 1] = sinf(ang); }
    }
}
__device__ __forceinline__ void norm_phase(const float* x0, const float* x1, const float* g, bf16_t* H, int wave, int lane) {
    const int gw = blockIdx.x * NWAVES + wave, NGW = gridDim.x * NWAVES;
    f32x4 nx[8];
    { const f32x4* xr = (const f32x4*)((gw < MP) ? x0 + (size_t)gw * DM : x1 + (size_t)(gw - MP) * DM) + lane;
#pragma unroll
      for (int j = 0; j < 8; ++j) nx[j] = xr[64 * j]; }
    for (int row = gw; row < MT; row += NGW) {
        f32x4 v[8]; float s = 0.f;
#pragma unroll
        for (int j = 0; j < 8; ++j) v[j] = nx[j];
        const int nr = row + NGW;
        if (nr < MT) { const f32x4* xr = (const f32x4*)((nr < MP) ? x0 + (size_t)nr * DM : x1 + (size_t)(nr - MP) * DM) + lane;
#pragma unroll
            for (int j = 0; j < 8; ++j) nx[j] = xr[64 * j]; }
#pragma unroll
        for (int j = 0; j < 8; ++j) s += (v[j][0] * v[j][0] + v[j][1] * v[j][1]) + (v[j][2] * v[j][2] + v[j][3] * v[j][3]);
#pragma unroll
        for (int o = 1; o < 64; o <<= 1) s += __shfl_xor(s, o);
        const float rs = 1.0f / sqrtf(s * (1.0f / DM) + RMS_EPS);
        u32x2* o8 = (u32x2*)(H + (size_t)row * DM) + lane;
#pragma unroll
        for (int j = 0; j < 8; ++j) { const f32x4 gv = ((const f32x4*)g)[lane + 64 * j]; u32x2 o;
            o.x = pk_bf16(v[j][0] * rs * gv[0], v[j][1] * rs * gv[1]); o.y = pk_bf16(v[j][2] * rs * gv[2], v[j][3] * rs * gv[3]); o8[64 * j] = o; }
    }
}

#define XB_TMO      128
#define XB_XCNT(j)  (256  + 64 * (j))
#define XB_XSUB(j)  (1280 + 64 * (j))
#define XB_XGEN(j)  (2304 + 64 * (j))
#define XB_TOP      3328
#define XB_TOPGEN   3392
#define XCD_BAR_WORDS 3456
#define XB_SPIN_CAP (1u << 18)

__device__ __forceinline__ unsigned xb_ld(unsigned* p)              { return __hip_atomic_load(p, __ATOMIC_RELAXED, __HIP_MEMORY_SCOPE_AGENT); }
__device__ __forceinline__ unsigned xb_add(unsigned* p, unsigned v) { return __hip_atomic_fetch_add(p, v, __ATOMIC_RELAXED, __HIP_MEMORY_SCOPE_AGENT); }
__device__ __forceinline__ unsigned xb_xcc_id() { return (unsigned)__builtin_amdgcn_s_getreg((3 << 11) | 20) & 0xFu; }
#define XB_SPIN(cond, bar) do { unsigned _sp = 0; while (cond) { __builtin_amdgcn_s_sleep(1); \
    if ((++_sp & 255u) == 0u) { if (xb_ld(&(bar)[XB_TMO])) break; if (_sp > XB_SPIN_CAP) { atomicAdd(&(bar)[XB_TMO], 1u); break; } } } } while (0)

struct XcdBarrier {
    unsigned* bar; unsigned x;
    volatile LAS unsigned* st;
};

__device__ __forceinline__ XcdBarrier xcd_barrier_post(unsigned* bar, volatile LAS unsigned* st) {
    XcdBarrier b; b.bar = bar; b.x = xb_xcc_id(); b.st = st;
    if (threadIdx.x == 0) (void)xb_add(&bar[XB_XCNT(b.x)], 1u);
    return b;
}
__device__ __forceinline__ void xcd_barrier_complete(unsigned* bar, unsigned x, unsigned& nloc, unsigned& nx) {
    const unsigned G = gridDim.x * gridDim.y * gridDim.z;
    unsigned sum, cnt, mine, sp = 0u;
    for (;;) {
        sum = 0u; cnt = 0u; mine = 0u;
#pragma unroll
        for (unsigned j = 0; j < 16; ++j) { const unsigned c = xb_ld(&bar[XB_XCNT(j)]); sum += c; cnt += (c > 0u) ? 1u : 0u; mine = (j == x) ? c : mine; }
        if (sum == G) break;
        __builtin_amdgcn_s_sleep(1);
        if ((++sp & 255u) == 0u) { if (xb_ld(&bar[XB_TMO])) break; if (sp > XB_SPIN_CAP) { atomicAdd(&bar[XB_TMO], 1u); break; } }
    }
    nloc = mine > 0u ? mine : 1u; nx = cnt > 0u ? cnt : 1u;
}

__device__ __forceinline__ void xcd_barrier(const XcdBarrier& b) {
    asm volatile("s_waitcnt vmcnt(0)" ::: "memory");
    __syncthreads();
    if (threadIdx.x == 0) {
        unsigned* bar = b.bar;
        __builtin_amdgcn_s_waitcnt(0);
        unsigned nloc = b.st[0], nx = b.st[1];
        if (nloc == 0u) { xcd_barrier_complete(bar, b.x, nloc, nx); b.st[0] = nloc; b.st[1] = nx; }
        const unsigned old = xb_add(&bar[XB_XSUB(b.x)], 1u);
        const unsigned gen = old / nloc;
        if (old + 1u == (gen + 1u) * nloc) {
            __builtin_amdgcn_fence(__ATOMIC_RELEASE, "agent");
            asm volatile("s_waitcnt vmcnt(0)" ::: "memory");
            const unsigned og = xb_add(&bar[XB_TOP], 1u);
            const unsigned tg = og / nx;
            if (og + 1u == (tg + 1u) * nx) xb_add(&bar[XB_TOPGEN], 1u);
            else XB_SPIN(xb_ld(&bar[XB_TOPGEN]) == tg, bar);
            __builtin_amdgcn_fence(__ATOMIC_ACQUIRE, "agent");
            xb_add(&bar[XB_XGEN(b.x)], 1u);
            asm volatile("s_waitcnt vmcnt(0)" ::: "memory");
        } else {
            XB_SPIN(xb_ld(&bar[XB_XGEN(b.x)]) == gen, bar);
            __builtin_amdgcn_fence(__ATOMIC_ACQUIRE, "agent");
            asm volatile("s_waitcnt vmcnt(0)" ::: "memory");
        }
    }
    __syncthreads();
}
namespace att {
constexpr int KP = 144, VP = 192, KBUF = 64 * KP, VBUF = 64 * VP, BUFB = KBUF + VBUF;
constexpr int L_TAB = 2 * BUFB, L_SLOT = L_TAB + (TABA_N + TABC_N) * 4;
static_assert(L_SLOT + 64 <= LDS_BYTES, "attention LDS map");
constexpr int N_BS = 768, N_BP = 192, N_A = 960, N_C = 1920, N_UNITS = N_BS + N_BP + N_A + N_C;
constexpr float THR = 5.0f;
typedef short v4i16_t __attribute__((ext_vector_type(4)));
__device__ __forceinline__ s16x4 vtr(const LAS unsigned char* p) { return __builtin_bit_cast(s16x4, __builtin_amdgcn_ds_read_tr16_b64_v4i16((LAS v4i16_t*)p)); }
#define MFMA32(a, b, c) __builtin_amdgcn_mfma_f32_32x32x16_bf16((a), (b), (c), 0, 0, 0)

struct UnitP { int rowbase, dil, rho, i0, t_lo, t_hi, qcol, kcol, vcol, gcol, ocol, tabidx, g, kvi; };

template <bool FAST>
__device__ __forceinline__ void softmax_step(f32x16& p0, f32x16& p1, float& m, float& l, f32x16& o0, f32x16& o1) {
    if (FAST) {
        float ls0 = 0.f, ls1 = 0.f;
#pragma unroll
        for (int r = 0; r < 16; ++r) { p0[r] = __builtin_amdgcn_exp2f(p0[r]); p1[r] = __builtin_amdgcn_exp2f(p1[r]); ls0 += p0[r]; ls1 += p1[r]; }
        l += ls0 + ls1;
        return;
    }
    float a = fmaxf(fmaxf(p0[0], p0[1]), p1[0]), b = fmaxf(fmaxf(p0[2], p0[3]), p1[1]); a = fmaxf(fmaxf(a, p1[2]), p1[3]);
#pragma unroll
    for (int r = 4; r < 16; r += 4) { a = fmaxf(fmaxf(a, p0[r]), p0[r + 1]); b = fmaxf(fmaxf(b, p0[r + 2]), p0[r + 3]); a = fmaxf(fmaxf(a, p1[r]), p1[r + 1]); b = fmaxf(fmaxf(b, p1[r + 2]), p1[r + 3]); }
    float rm = fmaxf(a, b);
    { auto rr = __builtin_amdgcn_permlane32_swap(__float_as_uint(rm), __float_as_uint(rm), false, false); rm = fmaxf(__uint_as_float(rr[0]), __uint_as_float(rr[1])); }
    if (__any(rm > m + THR)) { const float mn = fmaxf(m, rm), al = __builtin_amdgcn_exp2f(m - mn); m = mn; l *= al; o0 = o0 * al; o1 = o1 * al; }
    float ls0 = 0.f, ls1 = 0.f;
#pragma unroll
    for (int r = 0; r < 16; ++r) { p0[r] = __builtin_amdgcn_exp2f(p0[r] - m); p1[r] = __builtin_amdgcn_exp2f(p1[r] - m); ls0 += p0[r]; ls1 += p1[r]; }
    l += ls0 + ls1;
}
__device__ __forceinline__ bf16x8 pack8(const f32x16& x, int s) {
    u32x4 w; w.x = pk_bf16(x[8 * s], x[8 * s + 1]); w.y = pk_bf16(x[8 * s + 2], x[8 * s + 3]); w.z = pk_bf16(x[8 * s + 4], x[8 * s + 5]); w.w = pk_bf16(x[8 * s + 6], x[8 * s + 7]);
    return __builtin_bit_cast(bf16x8, w);
}
template <int MODE>
__device__ __forceinline__ void store_block(const Params& p, const UnitP& u, const f32x16& o0, const f32x16& o1, float m, float l, float m_sink, size_t qrow, int hq, int hi) {
    const bf16_t* P = (const bf16_t*)(p.ws + WS_P);
    float lt; { auto rr = __builtin_amdgcn_permlane32_swap(__float_as_uint(l), __float_as_uint(l), false, false); lt = __uint_as_float(rr[0]) + __uint_as_float(rr[1]); }
    if (MODE == 0) lt += __builtin_amdgcn_exp2f(m_sink - m);
    const float inv = __builtin_amdgcn_rcpf(lt);
    if (MODE != 2) {
        bf16_t* mix = (bf16_t*)(p.ws + WS_H) + qrow * DM + u.ocol + hq * 64 + 4 * hi;
        const bf16_t* gp = P + qrow * NP + u.gcol + hq * 64 + 4 * hi;
#pragma unroll
        for (int g = 0; g < 4; ++g) {
            const u32x2 g0 = *(const u32x2*)(gp + 8 * g), g1 = *(const u32x2*)(gp + 32 + 8 * g); u32x2 w0, w1;
            w0.x = pk_bf16(o0[4 * g] * inv * bf_lo(g0.x), o0[4 * g + 1] * inv * bf_hi(g0.x)); w0.y = pk_bf16(o0[4 * g + 2] * inv * bf_lo(g0.y), o0[4 * g + 3] * inv * bf_hi(g0.y));
            w1.x = pk_bf16(o1[4 * g] * inv * bf_lo(g1.x), o1[4 * g + 1] * inv * bf_hi(g1.x)); w1.y = pk_bf16(o1[4 * g + 2] * inv * bf_lo(g1.y), o1[4 * g + 3] * inv * bf_hi(g1.y));
            *(u32x2*)(mix + 8 * g) = w0; *(u32x2*)(mix + 32 + 8 * g) = w1;
        }
    } else {
        bf16_t* cs = (bf16_t*)(p.ws + WS_P) + qrow * NP + C_QC + (u.g * 8 + u.kvi * 4 + hq) * 64 + 4 * hi;
#pragma unroll
        for (int g = 0; g < 4; ++g) { u32x2 w0, w1;
            w0.x = pk_bf16(o0[4 * g] * inv, o0[4 * g + 1] * inv); w0.y = pk_bf16(o0[4 * g + 2] * inv, o0[4 * g + 3] * inv);
            w1.x = pk_bf16(o1[4 * g] * inv, o1[4 * g + 1] * inv); w1.y = pk_bf16(o1[4 * g + 2] * inv, o1[4 * g + 3] * inv);
            *(u32x2*)(cs + 8 * g) = w0; *(u32x2*)(cs + 32 + 8 * g) = w1; }
        if (hi == 0) ((float*)(p.ws + WS_LSE))[((size_t)u.g * MT + qrow) * 8 + u.kvi * 4 + hq] = m + __builtin_amdgcn_logf(lt);
    }
}
template <int MODE, bool SEQ, bool FAST>
__device__ __forceinline__ void tile_loop(const UnitP& u, const bf16_t* kg, const bf16_t* vg, size_t tstep, u32x4 kreg, u32x4 vreg, LAS unsigned char* kst, LAS unsigned char* vst,
                                          const LAS unsigned char* krd, const LAS unsigned char* vrd, const LAS float* btab, int iqa, int hi, int wt_lo, int wt_hi,
                                          const bf16x8 (&qa)[4], const bf16x8 (&qb)[4], float& ma, float& la, float& mb, float& lb, f32x16& oa0, f32x16& oa1, f32x16& ob0, f32x16& ob1) {
    for (int t = u.t_lo; t <= u.t_hi; ++t) {
        const int boff = ((t - u.t_lo) & 1) * BUFB;
        __syncthreads();
        if (t < u.t_hi) { kreg = *(const u32x4*)(kg + (size_t)(t + 1) * tstep); vreg = *(const u32x4*)(vg + (size_t)(t + 1) * tstep); }
        if (MODE == 1 || (t >= wt_lo && t <= wt_hi)) {
          const LAS float* bt = btab + (64 * t - iqa + 4 * hi);
          if (!SEQ) {
            f32x16 pa0 = {}, pa1 = {}, pb0 = {}, pb1 = {};
#pragma unroll
            for (int ds = 0; ds < 4; ++ds) {
                const bf16x8 k0 = *(const LAS bf16x8*)(krd + boff + ds * 32), k1 = *(const LAS bf16x8*)(krd + boff + 32 * KP + ds * 32);
                pa0 = MFMA32(k0, qa[ds], pa0); pa1 = MFMA32(k1, qa[ds], pa1); pb0 = MFMA32(k0, qb[ds], pb0); pb1 = MFMA32(k1, qb[ds], pb1);
            }
            if (!FAST) __builtin_amdgcn_sched_barrier(0);
            if (MODE != 1) {
#pragma unroll
                for (int r = 0; r < 16; ++r) { const int o = (r & 3) + 8 * (r >> 2);
                    pa0[r] += bt[o]; pa1[r] += bt[o + 32]; pb0[r] += bt[o - 32]; pb1[r] += bt[o]; }
            }
            softmax_step<FAST>(pa0, pa1, ma, la, oa0, oa1);
            softmax_step<FAST>(pb0, pb1, mb, lb, ob0, ob1);
            if (!FAST) __builtin_amdgcn_sched_barrier(0);
#pragma unroll
            for (int s = 0; s < 4; ++s) {
                const bf16x8 xa = (s < 2) ? pack8(pa0, s & 1) : pack8(pa1, s & 1), xb = (s < 2) ? pack8(pb0, s & 1) : pack8(pb1, s & 1);
                const LAS unsigned char* vb = vrd + boff + s * 16 * VP;
                const s16x4 a0 = vtr(vb), a1 = vtr(vb + 8 * VP), b0 = vtr(vb + 64), b1 = vtr(vb + 8 * VP + 64);
                const bf16x8 vf0 = __builtin_shufflevector(a0, a1, 0, 1, 2, 3, 4, 5, 6, 7), vf1 = __builtin_shufflevector(b0, b1, 0, 1, 2, 3, 4, 5, 6, 7);
                oa0 = MFMA32(vf0, xa, oa0); oa1 = MFMA32(vf1, xa, oa1); ob0 = MFMA32(vf0, xb, ob0); ob1 = MFMA32(vf1, xb, ob1);
                if (!FAST && s == 1) __builtin_amdgcn_sched_barrier(0);
            }
          } else {
#define ATT_ONE_BLOCK(QF, M_, L_, O0, O1, BOFS) do { \
            f32x16 p0 = {}, p1 = {}; \
            _Pragma("unroll") for (int ds = 0; ds < 4; ++ds) { \
                const bf16x8 k0 = *(const LAS bf16x8*)(krd + boff + ds * 32), k1 = *(const LAS bf16x8*)(krd + boff + 32 * KP + ds * 32); \
                p0 = MFMA32(k0, QF[ds], p0); p1 = MFMA32(k1, QF[ds], p1); } \
            __builtin_amdgcn_sched_barrier(0); \
            if (MODE != 1) { _Pragma("unroll") for (int r = 0; r < 16; ++r) { const int o = (r & 3) + 8 * (r >> 2); p0[r] += bt[o + (BOFS)]; p1[r] += bt[o + 32 + (BOFS)]; } } \
            softmax_step<FAST>(p0, p1, M_, L_, O0, O1); \
            __builtin_amdgcn_sched_barrier(0); \
            _Pragma("unroll") for (int s = 0; s < 4; ++s) { \
                const bf16x8 xs = (s < 2) ? pack8(p0, s & 1) : pack8(p1, s & 1); \
                const LAS unsigned char* vb = vrd + boff + s * 16 * VP; \
                const s16x4 a0 = vtr(vb), a1 = vtr(vb + 8 * VP), b0 = vtr(vb + 64), b1 = vtr(vb + 8 * VP + 64); \
                const bf16x8 vf0 = __builtin_shufflevector(a0, a1, 0, 1, 2, 3, 4, 5, 6, 7), vf1 = __builtin_shufflevector(b0, b1, 0, 1, 2, 3, 4, 5, 6, 7); \
                O0 = MFMA32(vf0, xs, O0); O1 = MFMA32(vf1, xs, O1); } \
            __builtin_amdgcn_sched_barrier(0); } while (0)
            ATT_ONE_BLOCK(qa, ma, la, oa0, oa1, 0);
            ATT_ONE_BLOCK(qb, mb, lb, ob0, ob1, -32);
#undef ATT_ONE_BLOCK
          }
        }
        if (t < u.t_hi) { *(LAS u32x4*)(kst + (BUFB - boff)) = kreg; *(LAS u32x4*)(vst + (BUFB - boff)) = vreg; }
    }
}
template <int MODE, bool FAST>
__device__ __forceinline__ void unit(LAS unsigned char* lds, const Params& p, const UnitP& u, int tid, int wave, int lane) {
    const bf16_t* P = (const bf16_t*)(p.ws + WS_P);
    const int r32 = lane & 31, hi = lane >> 5, hq = wave >> 1, sub = wave & 1;
    const int iqa = u.i0 + 64 * sub + r32;
    const size_t qrow_a = (size_t)(u.rowbase + u.rho + u.dil * iqa), qrow_b = qrow_a + (size_t)(32 * u.dil);
    constexpr int W = (MODE == 0) ? 128 : 64, TW = (MODE == 0) ? TABA_W : TABC_W, TC = (MODE == 0) ? 256 : 192;
    const int kk = tid >> 3, ch = tid & 7;
    const bf16_t* kg = P + (size_t)(u.rowbase + u.rho + u.dil * kk) * NP + u.kcol + ch * 8;
    const bf16_t* vg = P + (size_t)(u.rowbase + u.rho + u.dil * kk) * NP + u.vcol + ch * 8;
    const size_t tstep = (size_t)64 * u.dil * NP;
    u32x4 kreg = *(const u32x4*)(kg + (size_t)u.t_lo * tstep), vreg = *(const u32x4*)(vg + (size_t)u.t_lo * tstep);
    bf16x8 qa[4], qb[4];
#pragma unroll
    for (int ds = 0; ds < 4; ++ds) { qa[ds] = *(const bf16x8*)(P + qrow_a * NP + u.qcol + hq * 64 + ds * 16 + hi * 8); qb[ds] = *(const bf16x8*)(P + qrow_b * NP + u.qcol + hq * 64 + ds * 16 + hi * 8); }
    LAS unsigned char* kst = lds + kk * KP + ch * 16; LAS unsigned char* vst = lds + KBUF + kk * VP + ch * 16;
    *(LAS u32x4*)kst = kreg; *(LAS u32x4*)vst = vreg;
    asm volatile("" :: "v"(qa[0]), "v"(qa[1]), "v"(qa[2]), "v"(qa[3]), "v"(qb[0]), "v"(qb[1]), "v"(qb[2]), "v"(qb[3]));
    const LAS unsigned char* krd = lds + r32 * KP + hi * 16;
    const LAS unsigned char* vrd = lds + KBUF + (4 * hi + ((lane & 15) >> 2)) * VP + ((lane >> 4) & 1) * 32 + (lane & 3) * 8;
    const LAS float* btab = (const LAS float*)(lds + L_TAB) + u.tabidx + hq * TW + TC;
    float m_sink = -1e30f;
    if (MODE == 0) m_sink = p.sink[u.g * 12 + u.kvi * 4 + hq] * LOG2E;
    float ma = FAST ? 0.f : m_sink, mb = ma, la = 0.f, lb = 0.f;
    f32x16 oa0 = {}, oa1 = {}, ob0 = {}, ob1 = {};
    int wt_lo = u.t_lo, wt_hi = u.t_hi;
    if (MODE != 1) { const int c = (u.i0 >> 6) + sub; wt_lo = c - W / 64 > wt_lo ? c - W / 64 : wt_lo; wt_hi = c + W / 64 < wt_hi ? c + W / 64 : wt_hi; }
    tile_loop<MODE, false, FAST>(u, kg, vg, tstep, kreg, vreg, kst, vst, krd, vrd, btab, iqa, hi, wt_lo, wt_hi, qa, qb, ma, la, mb, lb, oa0, oa1, ob0, ob1);
    store_block<MODE>(p, u, oa0, oa1, ma, la, m_sink, qrow_a, hq, hi);
    store_block<MODE>(p, u, ob0, ob1, mb, lb, m_sink, qrow_b, hq, hi);
}

__device__ __forceinline__ void seqblk_decode(int sb, int& rowbase, int& S, int& blk) {
    if (sb < 256) { rowbase = MP + (sb >> 5) * 4096; S = 4096; blk = sb & 31; } else { sb -= 256; rowbase = (sb >> 4) * 2048; S = 2048; blk = sb & 15; }
}
__device__ __forceinline__ void phase(LAS unsigned char* lds, const Params& p, int layer, int cslot, int ubeg, int uend, int tid, int wave, int lane) {
    { const float* gt = (const float*)(p.ws + WS_TAB); LAS float* lt = (LAS float*)(lds + L_TAB);
      for (int i = tid; i < TABA_N + TABC_N; i += NTHREADS) lt[i] = gt[i]; }
    unsigned* ctr = (unsigned*)(p.ws + WS_CTL) + 64 * cslot;
    const bool fast = __builtin_amdgcn_readfirstlane(((const int*)(p.ws + WS_TAB))[TABA_N + TABC_N + ROPE_N + layer]) != 0;
    volatile LAS int* slot = (volatile LAS int*)(lds + L_SLOT);
    int nxt = 0;
    if (tid == 0) { nxt = ubeg + (int)atomicAdd(ctr, 1u); *slot = nxt; }
    __syncthreads();
    int un = *slot;
    while (un < uend) {
        if (tid == 0) nxt = ubeg + (int)atomicAdd(ctr, 1u);
        UnitP u; u.dil = 1; u.rho = 0; u.g = 0; u.kvi = 0; u.tabidx = 0; u.gcol = 0; u.ocol = 0;
        if (un < N_BS + N_BP) {
            int b, kvh, blk, S;
            if (un < N_BS) { b = un / 96; const int rem = un % 96; kvh = rem >> 5; blk = rem & 31; u.rowbase = MP + b * 4096; S = 4096; }
            else { const int v = un - N_BS; b = v / 48; const int rem = v % 48; kvh = rem >> 4; blk = rem & 15; u.rowbase = b * 2048; S = 2048; }
            u.i0 = blk * 128; u.t_lo = 0; u.t_hi = S / 64 - 1; u.qcol = C_QB + kvh * 256; u.kcol = C_KB + kvh * 64; u.vcol = C_VB + kvh * 64; u.gcol = C_GB + kvh * 256; u.ocol = 768 + kvh * 256;
            if (fast) unit<1, true>(lds, p, u, tid, wave, lane); else unit<1, false>(lds, p, u, tid, wave, lane);
        } else if (un < N_BS + N_BP + N_A) {
            const int v = un - (N_BS + N_BP), sb = v / 3, kvh = v % 3; int S, blk; seqblk_decode(sb, u.rowbase, S, blk);
            u.i0 = blk * 128; u.t_lo = 2 * blk - 2 < 0 ? 0 : 2 * blk - 2; u.t_hi = 2 * blk + 3 > S / 64 - 1 ? S / 64 - 1 : 2 * blk + 3;
            u.qcol = C_QA + kvh * 256; u.kcol = C_KA + kvh * 64; u.vcol = C_VA + kvh * 64; u.gcol = C_GA + kvh * 256; u.ocol = kvh * 256; u.tabidx = kvh * 4 * TABA_W; u.g = layer; u.kvi = kvh;
            if (fast) unit<0, true>(lds, p, u, tid, wave, lane); else unit<0, false>(lds, p, u, tid, wave, lane);
        } else {
            const int v = un - (N_BS + N_BP + N_A), g = v / 640, r = v % 640, sb = r >> 1, kvi = r & 1; int S, blk; seqblk_decode(sb, u.rowbase, S, blk);
            const int dsh = 2 * g, nb = (S >> dsh) >> 7;
            u.dil = 1 << dsh; u.rho = blk / nb; const int lb = blk % nb; u.i0 = lb * 128; u.t_lo = 2 * lb - 1 < 0 ? 0 : 2 * lb - 1; u.t_hi = 2 * lb + 2 > 2 * nb - 1 ? 2 * nb - 1 : 2 * lb + 2;
            u.qcol = C_QC + (g * 8 + kvi * 4) * 64; u.kcol = C_KC + (g * 2 + kvi) * 64; u.vcol = C_VC + (g * 2 + kvi) * 64; u.tabidx = TABA_N + (g * 8 + kvi * 4) * TABC_W; u.g = g; u.kvi = kvi;
            if (fast) unit<2, true>(lds, p, u, tid, wave, lane); else unit<2, false>(lds, p, u, tid, wave, lane);
        }
        __syncthreads();
        if (tid == 0) *slot = nxt;
        __syncthreads();
        un = *slot;
    }
}
__device__ __forceinline__ void combine_one(const float* lse, const bf16_t* P, bf16_t* mix, size_t i) {
    const size_t row = i >> 6; const int hc = (int)(i >> 3) & 7, chk = (int)i & 7;
    const float l0 = lse[row * 8 + hc], l1 = lse[((size_t)MT + row) * 8 + hc], l2 = lse[((size_t)2 * MT + row) * 8 + hc];
    const bf16_t* cq = P + row * NP + C_QC + hc * 64 + chk * 8;
    const u32x4 a = *(const u32x4*)(cq), b = *(const u32x4*)(cq + 512), c = *(const u32x4*)(cq + 1024), gt = *(const u32x4*)(P + row * NP + C_GC + hc * 64 + chk * 8);
    const float mx = fmaxf(l0, fmaxf(l1, l2));
    float w0 = __builtin_amdgcn_exp2f(l0 - mx), w1 = __builtin_amdgcn_exp2f(l1 - mx), w2 = __builtin_amdgcn_exp2f(l2 - mx);
    const float inv = 1.0f / (w0 + w1 + w2); w0 *= inv; w1 *= inv; w2 *= inv;
    u32x4 o;
#pragma unroll
    for (int k = 0; k < 4; ++k) {
        const float lo = (w0 * bf_lo(a[k]) + w1 * bf_lo(b[k]) + w2 * bf_lo(c[k])) * bf_lo(gt[k]), hi = (w0 * bf_hi(a[k]) + w1 * bf_hi(b[k]) + w2 * bf_hi(c[k])) * bf_hi(gt[k]);
        o[k] = pk_bf16(lo, hi);
    }
    *(u32x4*)(mix + row * DM + 1536 + hc * 64 + chk * 8) = o;
}
__device__ __forceinline__ void combine_phase(const Params& p, int tid) {
    const float* lse = (const float*)(p.ws + WS_LSE);
    const bf16_t* P = (const bf16_t*)(p.ws + WS_P); bf16_t* mix = (bf16_t*)(p.ws + WS_H);
    const size_t stride = (size_t)gridDim.x * NTHREADS, total = (size_t)MT * 64;
    size_t i = (size_t)blockIdx.x * NTHREADS + tid;
    for (; i + 3 * stride < total; i += 4 * stride) { combine_one(lse, P, mix, i); combine_one(lse, P, mix, i + stride); combine_one(lse, P, mix, i + 2 * stride); combine_one(lse, P, mix, i + 3 * stride); }
    for (; i < total; i += stride) combine_one(lse, P, mix, i);
}
}

typedef const __attribute__((address_space(4))) Params* KParamsPtr;
__device__ __forceinline__ Params fresh_params() {
#if defined(__HIP_DEVICE_COMPILE__)
    KParamsPtr pp = (KParamsPtr)__builtin_amdgcn_kernarg_segment_ptr(); asm volatile("" : "+s"(pp)); Params r;
    r.x_prompt = pp->x_prompt; r.x_sample = pp->x_sample; r.ln_g = pp->ln_g; r.w_in = pp->w_in; r.qna = pp->qna; r.kna = pp->kna; r.sink = pp->sink; r.qnb = pp->qnb; r.knb = pp->knb;
    r.qnc = pp->qnc; r.knc = pp->knc; r.rel_bias = pp->rel_bias; r.w_out = pp->w_out; r.out = pp->out; r.ws = pp->ws; return r;
#else
    return Params{};
#endif
}
#define PHASE_IDS() int tid_l = threadIdx.x; asm volatile("" : "+v"(tid_l)); const int tid = tid_l, lane = tid & 63, wave = __builtin_amdgcn_readfirstlane(tid >> 6); (void)lane; (void)wave
#define GRID_BAR() do { XcdBarrier b_; b_.bar = (unsigned*)(fresh_params().ws + WS_CTL) + CW_BAR; b_.x = xb_xcc_id(); b_.st = (volatile LAS unsigned*)(lds + XBAR_LDS); xcd_barrier(b_); } while (0)
__global__ void __launch_bounds__(NTHREADS, 2) fwd_megakernel(Params p_unused) {
    extern __shared__ __attribute__((aligned(16))) unsigned char lds_raw[];
    LAS unsigned char* lds = (LAS unsigned char*)lds_raw;
    if (threadIdx.x < 2) ((volatile LAS unsigned*)(lds + XBAR_LDS))[threadIdx.x] = 0u;
    __syncthreads();
    { const Params p = fresh_params(); (void)xcd_barrier_post((unsigned*)(p.ws + WS_CTL) + CW_BAR, (volatile LAS unsigned*)(lds + XBAR_LDS)); }
#ifndef NO_PRO
    { const Params p = fresh_params(); PHASE_IDS(); prologue_phase(p, lds, tid, wave, lane); }
#if defined(REP_PRO)
    { const Params p = fresh_params(); PHASE_IDS(); prologue_phase(p, lds, tid, wave, lane); }
#endif
#endif
#if defined(REP_SYNC)
    for (int i = 0; i < REP_SYNC; ++i) GRID_BAR();
#endif
    for (int layer = 0; layer < 2; ++layer) {
        asm volatile("" : "+s"(layer));
#ifndef NO_NORM
        if (layer == 0) { const Params p = fresh_params(); PHASE_IDS();
          const float* x0 = layer == 0 ? p.x_prompt : p.out; const float* x1 = layer == 0 ? p.x_sample : p.out + (size_t)MP * DM;
          norm_phase(x0, x1, p.ln_g + layer * DM, (bf16_t*)(p.ws + WS_H), wave, lane);
#if defined(REP_NORM)
          norm_phase(x0, x1, p.ln_g + layer * DM, (bf16_t*)(p.ws + WS_H), wave, lane);
#endif
        }
#endif
        if (layer == 0) cg::this_grid().sync();
#if defined(NAIVE_G1)
        { const Params p = fresh_params(); PHASE_IDS(); naive_g1(p, layer, wave, lane); }
#endif
#if defined(NAIVE_G2X)
#endif
#ifndef NO_G1
        { const Params p = fresh_params();
          pg8::Gemm g{(const bf16_t*)(p.ws + (layer == 0 ? WS_H : WS_HQ)), (const bf16_t*)(p.ws + WS_WIN) + (size_t)layer * NP * DM, MT, NP, DM}; pg8::StaticOrder S; S.init(MT, NP, (int)gridDim.x, (int)blockIdx.x);
          pg8::EpiProj E{(bf16_t*)(p.ws + WS_P), p.qna + layer * 64, p.kna + layer * 64, p.qnb + layer * 64, p.knb + layer * 64, p.qnc + layer * 64, p.knc + layer * 64, (const float*)(p.ws + WS_TAB) + TABA_N + TABC_N, layer == 0 ? (const float*)nullptr : (const float*)(p.ws + WS_ROWSS)};
          pg8::gemm_phase<pg8::EpiProj, pg8::StaticOrder, true, true>(lds, g, S, E);
#if defined(REP_G1)
          pg8::gemm_phase<pg8::EpiProj, pg8::StaticOrder, true, true>(lds, g, S, E);
#endif
        }
#endif
        GRID_BAR();
#ifndef NO_ATT
        { const Params p = fresh_params(); PHASE_IDS(); att::phase(lds, p, layer, layer, 0, att::N_UNITS, tid, wave, lane); }
#if defined(REP_ATT)
        GRID_BAR();
        { const Params p = fresh_params(); PHASE_IDS(); att::phase(lds, p, layer, layer + 2, REP_ATT_LO, REP_ATT_HI, tid, wave, lane); }
#endif
#endif
        GRID_BAR();
#ifndef NO_CMB
        { const Params p = fresh_params(); PHASE_IDS(); att::combine_phase(p, tid); }
#if defined(REP_CMB)
        { const Params p = fresh_params(); PHASE_IDS(); att::combine_phase(p, tid); }
#endif
#endif
        GRID_BAR();
#if defined(NAIVE_MASK)
        { const Params p = fresh_params(); PHASE_IDS(); naive_attention(p, layer, wave, lane); }
        GRID_BAR();
#endif
#if defined(NAIVE_G2)
        { const Params p = fresh_params(); PHASE_IDS(); naive_g2(p, layer, wave, lane); }
#endif
#ifndef NO_G2
        { const Params p = fresh_params();
          const float* x0 = layer == 0 ? p.x_prompt : p.out; const float* x1 = layer == 0 ? p.x_sample : p.out + (size_t)MP * DM;
          pg8::Gemm g{(const bf16_t*)(p.ws + WS_H), (const bf16_t*)(p.ws + WS_WOUT) + (size_t)layer * DM * DM, MT, DM, DM}; pg8::StaticOrder S; S.init(MT, DM, (int)gridDim.x, (int)blockIdx.x);
          pg8::EpiRes E{x0, x1, p.out, layer == 0 ? (bf16_t*)(p.ws + WS_HQ) : (bf16_t*)nullptr, p.ln_g + DM, (float*)(p.ws + WS_ROWSS)};
          pg8::gemm_phase<pg8::EpiRes, pg8::StaticOrder, true, true>(lds, g, S, E); }
#endif
        if (layer == 0) GRID_BAR();
    }
}

extern "C" void kernel_launch(void* const* d_in, const int* in_sizes, int n_in, void* d_out, int out_size, void* d_ws, size_t ws_size, hipStream_t stream) {
    static int grid_blocks = 0;
    if (grid_blocks == 0) {
        if (n_in != 13 || out_size != MT * DM || ws_size < WS_END) { fprintf(stderr, "kernel_launch: unexpected shapes (n_in %d, out %d, ws %zu < %zu)\n", n_in, out_size, ws_size, (size_t)WS_END); grid_blocks = -1; return; }
        int dev = 0, cus = 0, per_cu = 0;
        hipGetDevice(&dev); hipDeviceGetAttribute(&cus, hipDeviceAttributeMultiprocessorCount, dev);
        hipFuncSetAttribute((const void*)fwd_megakernel, hipFuncAttributeMaxDynamicSharedMemorySize, LDS_BYTES);
        hipOccupancyMaxActiveBlocksPerMultiprocessor(&per_cu, (const void*)fwd_megakernel, NTHREADS, LDS_BYTES);
        if (per_cu < 1) { fprintf(stderr, "kernel_launch: occupancy query says %d blocks/CU\n", per_cu); per_cu = 1; }
        (void)hipGetLastError();
        grid_blocks = cus * 1;
    }
    if (grid_blocks < 0) return;
    hipMemsetAsync((char*)d_ws + WS_CTL, 0, CTL_BYTES, stream);
    Params p{};
    p.x_prompt = (const float*)d_in[0]; p.x_sample = (const float*)d_in[1]; p.ln_g = (const float*)d_in[2]; p.w_in = (const float*)d_in[3]; p.qna = (const float*)d_in[4]; p.kna = (const float*)d_in[5];
    p.sink = (const float*)d_in[6]; p.qnb = (const float*)d_in[7]; p.knb = (const float*)d_in[8]; p.qnc = (const float*)d_in[9]; p.knc = (const float*)d_in[10]; p.rel_bias = (const float*)d_in[11];
    p.w_out = (const float*)d_in[12]; p.out = (float*)d_out; p.ws = (unsigned char*)d_ws;
    void* args[] = {&p};
    hipError_t e = hipLaunchCooperativeKernel((const void*)fwd_megakernel, dim3(grid_blocks), dim3(NTHREADS), args, LDS_BYTES, stream);
    if (e != hipSuccess) fprintf(stderr, "cooperative launch failed: %s (grid %d)\n", hipGetErrorString(e), grid_blocks);
}
```
